# Optimizing an MI355X kernel written in HIP

```python
import math
import jax, jax.numpy as jnp
from jax import lax
import numpy as np

D_MODEL = 2048
BATCH = 4
SEQ = 4096
DEPTH = 2

N_META = 16
EPS = 1e-6
D_CONV = D_MODEL // 2
CONV_WIDTH = 3
N_HEADS = D_MODEL // 128
QK_NOPE = 128
QK_ROPE = 64
QK_HEAD = QK_NOPE + QK_ROPE
V_HEAD = 128
Q_LORA = 512
KV_LORA = 512
ROPE_THETA = 10000.0
Q_BLOCK = 128
D_POOL = D_MODEL // 2
POOL_WINDOWS = (2, 4, 8, 16)
POOL_GROUP = D_POOL // len(POOL_WINDOWS)
N_BRANCH = 3
D_FF = 4 * D_MODEL
D_IN = 3 * D_CONV + Q_LORA + KV_LORA + QK_ROPE + D_POOL + N_BRANCH * D_MODEL
IN_SPLITS = (3 * D_CONV,
             3 * D_CONV + Q_LORA,
             3 * D_CONV + Q_LORA + KV_LORA,
             3 * D_CONV + Q_LORA + KV_LORA + QK_ROPE,
             3 * D_CONV + Q_LORA + KV_LORA + QK_ROPE + D_POOL)

kernel_name = 'hybrid_gated_conv_mla_pool_block'


def rms_norm(x, g):
    xf = x.astype(jnp.float32)
    y = xf * lax.rsqrt(jnp.mean(xf * xf, axis=-1, keepdims=True) + EPS)
    return (y * g.astype(jnp.float32)).astype(x.dtype)


def rope_tables(T, dtype):
    pos = jnp.arange(T, dtype=jnp.float32)
    inv = ROPE_THETA ** (-jnp.arange(0, QK_ROPE, 2, dtype=jnp.float32) / QK_ROPE)
    ang = pos[:, None] * inv[None, :]
    return jnp.cos(ang).astype(dtype), jnp.sin(ang).astype(dtype)


def apply_rope_tail(x, cos, sin):
    x_nope, x_rope = x[..., :QK_NOPE], x[..., QK_NOPE:]
    x1, x2 = jnp.split(x_rope, 2, axis=-1)
    c, s = cos[None, :, None, :], sin[None, :, None, :]
    return jnp.concatenate([x_nope, x1 * c - x2 * s, x2 * c + x1 * s], axis=-1)


def causal_short_conv(u, w):
    T = u.shape[1]
    up = jnp.pad(u, ((0, 0), (CONV_WIDTH - 1, 0), (0, 0)))
    return sum(w[j] * up[:, j:j + T] for j in range(CONV_WIDTH))


def causal_block_attention(q, k, v):
    B, T, H, dk = q.shape
    Tp = -(-T // Q_BLOCK) * Q_BLOCK
    pad = ((0, 0), (0, Tp - T), (0, 0), (0, 0))
    q, k, v = jnp.pad(q, pad), jnp.pad(k, pad), jnp.pad(v, pad)
    nb = Tp // Q_BLOCK
    q_blocks = q.reshape(B, nb, Q_BLOCK, H, dk).swapaxes(0, 1)
    k_pos = jnp.arange(Tp)
    scale = dk ** -0.5

    def one_block(args):
        qb, blk = args
        s = jnp.einsum('bqhd,bkhd->bhqk', qb, k).astype(jnp.float32) * scale
        q_pos = blk * Q_BLOCK + jnp.arange(Q_BLOCK)
        s = jnp.where(q_pos[:, None] >= k_pos[None, :], s, -jnp.inf)
        p = jax.nn.softmax(s, axis=-1).astype(v.dtype)
        return jnp.einsum('bhqk,bkhd->bqhd', p, v)

    out = lax.map(one_block, (q_blocks, jnp.arange(nb)))
    return out.swapaxes(0, 1).reshape(B, Tp, H, -1)[:, :T]


def multiscale_pool(u, pool_w, pool_scale):
    B, T, _ = u.shape
    uf = u.astype(jnp.float32)
    groups = jnp.split(uf, len(POOL_WINDOWS), axis=-1)
    seen = jnp.arange(1, T + 1, dtype=jnp.float32)
    outs = []
    for g, w in zip(groups, POOL_WINDOWS):
        cs = jnp.cumsum(g, axis=1)
        lagged = jnp.pad(cs, ((0, 0), (w, 0), (0, 0)))[:, :T]
        count = jnp.minimum(seen, float(w))[None, :, None]
        outs.append((cs - lagged) / count - g)
    pooled = jnp.stack(outs, axis=2).astype(u.dtype)
    mixed = jnp.einsum('btgc,gcd->btgd', pooled, pool_w).reshape(B, T, D_POOL)
    return mixed * pool_scale


def hybrid_layer(x, cos, sin, attn_norm, w_in, conv_w, q_lat_norm, kv_lat_norm, w_uq, w_ukv,
                 q_norm, k_norm, pool_w, pool_scale, w_branch_a, w_branch_b, w_branch_c, w_o,
                 mlp_norm, w_up, w_down):
    B, T, _ = x.shape
    h = rms_norm(x, attn_norm)
    proj = h @ w_in
    a_in, q_lat, kv_lat, k_rope, pool_in, gate_logits = jnp.split(proj, IN_SPLITS, axis=-1)

    u_a, b_a, c_a = jnp.split(a_in, 3, axis=-1)
    y_a = b_a * causal_short_conv(c_a * u_a, conv_w)

    q = (rms_norm(q_lat, q_lat_norm) @ w_uq).reshape(B, T, N_HEADS, QK_HEAD)
    kv = (rms_norm(kv_lat, kv_lat_norm) @ w_ukv).reshape(B, T, N_HEADS, QK_NOPE + V_HEAD)
    k_nope, v = kv[..., :QK_NOPE], kv[..., QK_NOPE:]
    k = jnp.concatenate(
        [k_nope, jnp.broadcast_to(k_rope[:, :, None, :], (B, T, N_HEADS, QK_ROPE))], axis=-1)
    q = apply_rope_tail(rms_norm(q, q_norm), cos, sin)
    k = apply_rope_tail(rms_norm(k, k_norm), cos, sin)
    y_b = causal_block_attention(q, k, v).reshape(B, T, N_HEADS * V_HEAD)

    y_c = multiscale_pool(pool_in, pool_w, pool_scale)

    gates = jax.nn.sigmoid(gate_logits).reshape(B, T, N_BRANCH, D_MODEL)
    merged = (gates[:, :, 0] * (y_a @ w_branch_a)
              + gates[:, :, 1] * (y_b @ w_branch_b)
              + gates[:, :, 2] * (y_c @ w_branch_c))
    x = x + merged @ w_o

    h2 = rms_norm(x, mlp_norm)
    return x + jnp.square(jax.nn.relu(h2 @ w_up)) @ w_down


def setup_inputs(seed: int = 0) -> dict:
    key = jax.random.key(seed)
    ks = jax.random.split(key, 24)
    f32 = jnp.float32

    def w(k, shape, fan_in):
        return jax.random.normal(k, shape, f32) * fan_in ** -0.5

    def gain(k, shape):
        return 1.0 + 0.05 * jax.random.normal(k, shape, f32)

    L = DEPTH
    return {
        'x': jax.random.normal(ks[0], (BATCH, SEQ, D_MODEL), f32),
        'meta_tokens': jax.random.normal(ks[1], (N_META, D_MODEL), f32),
        'attn_norm': gain(ks[2], (L, D_MODEL)),
        'w_in': w(ks[3], (L, D_MODEL, D_IN), D_MODEL),
        'conv_w': w(ks[4], (L, CONV_WIDTH, D_CONV), CONV_WIDTH),
        'q_lat_norm': gain(ks[5], (L, Q_LORA)),
        'kv_lat_norm': gain(ks[6], (L, KV_LORA)),
        'w_uq': w(ks[7], (L, Q_LORA, N_HEADS * QK_HEAD), Q_LORA),
        'w_ukv': w(ks[8], (L, KV_LORA, N_HEADS * (QK_NOPE + V_HEAD)), KV_LORA),
        'q_norm': gain(ks[9], (L, QK_HEAD)),
        'k_norm': gain(ks[10], (L, QK_HEAD)),
        'pool_w': w(ks[11], (L, len(POOL_WINDOWS), POOL_GROUP, POOL_GROUP), POOL_GROUP),
        'pool_scale': gain(ks[12], (L, D_POOL)),
        'w_branch_a': w(ks[13], (L, D_CONV, D_MODEL), D_CONV),
        'w_branch_b': w(ks[14], (L, N_HEADS * V_HEAD, D_MODEL), N_HEADS * V_HEAD),
        'w_branch_c': w(ks[15], (L, D_POOL, D_MODEL), D_POOL),
        'w_o': w(ks[16], (L, D_MODEL, D_MODEL), D_MODEL),
        'mlp_norm': gain(ks[17], (L, D_MODEL)),
        'w_up': w(ks[18], (L, D_MODEL, D_FF), D_MODEL),
        'w_down': w(ks[19], (L, D_FF, D_MODEL), D_FF),
    }


def reference(x, meta_tokens, attn_norm, w_in, conv_w, q_lat_norm, kv_lat_norm, w_uq, w_ukv,
              q_norm, k_norm, pool_w, pool_scale, w_branch_a, w_branch_b, w_branch_c, w_o,
              mlp_norm, w_up, w_down):
    B = x.shape[0]
    meta = jnp.broadcast_to(meta_tokens[None].astype(x.dtype), (B, N_META, D_MODEL))
    h = jnp.concatenate([meta, x], axis=1)
    cos, sin = rope_tables(h.shape[1], h.dtype)
    for l in range(DEPTH):
        h = hybrid_layer(h, cos, sin, attn_norm[l], w_in[l], conv_w[l], q_lat_norm[l],
                         kv_lat_norm[l], w_uq[l], w_ukv[l], q_norm[l], k_norm[l], pool_w[l],
                         pool_scale[l], w_branch_a[l], w_branch_b[l], w_branch_c[l], w_o[l],
                         mlp_norm[l], w_up[l], w_down[l])
    return h[:, N_META:]
```

```cpp
#include <hip/hip_runtime.h>
#include <hip/hip_cooperative_groups.h>
#include <cstdio>
#include <cstdint>
namespace cg = cooperative_groups;

#define LAS __attribute__((address_space(3)))
typedef unsigned short bf16_t;
typedef short bf16x8 __attribute__((ext_vector_type(8)));
typedef short s16x4 __attribute__((ext_vector_type(4)));
typedef float f32x4 __attribute__((ext_vector_type(4)));
typedef float f32x16 __attribute__((ext_vector_type(16)));
typedef unsigned u32x4 __attribute__((ext_vector_type(4)));
typedef unsigned u32x2 __attribute__((ext_vector_type(2)));

constexpr int DM = 2048, NBATCH = 4, SEQ = 4096, NMETA = 16, TT = SEQ + NMETA;
constexpr int MREAL = NBATCH * SEQ;
constexpr int MVALID = MREAL + NMETA;
constexpr int MP = 16640;
constexpr int NH = 16, DQK = 192, DV = 128;
constexpr int N1 = 5376;
constexpr int C_QLAT = 3072, C_KVLAT = 3584, C_KROPE = 4096, C_POOL = 4160, N1SRC = 5184;
constexpr int NG = 6144, DIN = 11328, DFF = 8192;
constexpr float EPS = 1e-6f;

constexpr size_t SZ_WIN = (size_t)(N1 + NG) * DM * 2, SZ_WUQ = (size_t)3072 * 512 * 2, SZ_WUKV = (size_t)4096 * 512 * 2, SZ_WPOOL = (size_t)1024 * 256 * 2;
constexpr size_t SZ_WA = (size_t)2048 * 1024 * 2, SZ_WB = (size_t)2048 * 2048 * 2, SZ_WUP = (size_t)DFF * DM * 2;
constexpr size_t OFF_WIN = 0, OFF_WUQ = OFF_WIN + SZ_WIN, OFF_WUKV = OFF_WUQ + SZ_WUQ, OFF_WPOOL = OFF_WUKV + SZ_WUKV, OFF_WA = OFF_WPOOL + SZ_WPOOL,
                 OFF_WB = OFF_WA + SZ_WA, OFF_WC = OFF_WB + SZ_WB, OFF_WO = OFF_WC + SZ_WA, OFF_WUP = OFF_WO + SZ_WB, OFF_WDN = OFF_WUP + SZ_WUP, OFF_WEND = OFF_WDN + SZ_WUP;
constexpr size_t OFF_XB = OFF_WEND;
constexpr size_t OFF_P1 = OFF_XB + (size_t)MP * DM * 2;
constexpr size_t OFF_Q = OFF_P1 + (size_t)MP * N1 * 2;
constexpr size_t OFF_KF = OFF_Q + (size_t)MP * 3072 * 2;
constexpr size_t OFF_V = OFF_KF + (size_t)MP * 3072 * 2;
constexpr size_t OFF_Z = OFF_V + (size_t)MP * 2048 * 2;
constexpr size_t OFF_G = OFF_KF;
constexpr size_t OFF_H = OFF_Q;
constexpr size_t OFF_XM = OFF_Z + (size_t)MP * 1024 * 2;
constexpr size_t OFF_SS = OFF_XM + (size_t)256 * DM * 4;
constexpr size_t OFF_CS = OFF_SS + (size_t)4 * MP * 4;
constexpr size_t OFF_BAR = OFF_CS + (size_t)2 * TT * 32 * 4;
constexpr size_t BAR_BYTES = 16384;
constexpr size_t WS_NEED = OFF_BAR + BAR_BYTES;
static_assert(OFF_G + (size_t)MP * NG * 2 <= OFF_XM && OFF_H + (size_t)MP * DFF * 2 <= OFF_XM, "overlays");

constexpr int LDS_BAR_OFF = 155648, LDS_BYTES = 155648 + 64;
#ifndef SKIP
#define SKIP 0
#endif

__device__ __forceinline__ unsigned cvt_pk_bf16(float lo, float hi) { unsigned r; asm volatile("v_cvt_pk_bf16_f32 %0, %1, %2" : "=v"(r) : "v"(lo), "v"(hi)); return r; }
__device__ __forceinline__ float bf2f(unsigned v) { return __uint_as_float(v << 16); }
__device__ __forceinline__ float bflo(unsigned w) { return __uint_as_float(w << 16); }
__device__ __forceinline__ float bfhi(unsigned w) { return __uint_as_float(w & 0xffff0000u); }
__device__ __forceinline__ bf16_t f2bf(float f) { return (bf16_t)(cvt_pk_bf16(f, 0.f) & 0xffffu); }
__device__ __forceinline__ float wave_sum(float v) {
#pragma unroll
    for (int o = 1; o < 64; o <<= 1) v += __shfl_xor(v, o);
    return v;
}
__device__ __forceinline__ int opaque_tid() { int t = threadIdx.x; asm volatile("" : "+v"(t)); return t; }
__device__ __forceinline__ int tokrow(int b, int p) { return p < NMETA ? MREAL + p : b * SEQ - NMETA + (p < TT ? p : TT - 1); }

namespace pg8 {
constexpr int BM = 256, BK = 64, HALF = 128, HTB = HALF * BK * 2, STAGE_BYTES = 8 * HTB, NXCD = 8, WGM = 8;
__device__ __forceinline__ int lds_byte(int r, int c) { const int st = (r >> 4) * 2 + (c >> 5), rr = r & 15, cc = c & 31, ob = rr * 64 + cc * 2; return st * 1024 + (ob ^ (((ob >> 9) & 1) << 5)); }
__device__ __forceinline__ void stage_rc(int b, int& R, int& C) { const int st = b / 1024, sb = b % 1024, swz = sb ^ (((sb >> 9) & 1) << 5); R = (st >> 1) * 16 + swz / 64; C = (st & 1) * 32 + (swz % 64) / 2; }
__device__ __forceinline__ int perm32(int rho) { const int n = rho >> 4, i = rho & 15; return 8 * (i >> 2) + 4 * n + (i & 3); }

struct Unit { int pm, pn; };

struct StaticOrder {
    int nM, nN, nwg, G, c;
    __device__ void init(int nM_, int nN_, int G_, int c_) { nM = nM_; nN = nN_; nwg = nM * nN; G = G_; c = c_; }
    __device__ bool next(int i, Unit& u) const {
        const long L = (long)i * G + c; if (L >= nwg) return false;
        int wgid = (int)L; { const int q = nwg / NXCD, r = nwg % NXCD, xcd = wgid % NXCD, off = wgid / NXCD; wgid = (xcd < r ? xcd * (q + 1) : r * (q + 1) + (xcd - r) * q) + off; }
        const int nig = WGM * nN, gid = wgid / nig, fm = gid * WGM, gsz = (nM - fm) < WGM ? (nM - fm) : WGM;
        u.pm = fm + ((wgid % nig) % gsz); u.pn = (wgid % nig) / gsz; return true;
    }
};
struct GDesc {
    const char* A; const char* Bt; int lda, ldb, nt, nN, amode, epi;
    bf16_t* O; int ldc; const float* ss; float* ssacc; const bf16_t* Gt; const float* src; float* dst; int act, first; unsigned char* ws; int lastout;
};
__device__ __forceinline__ size_t a_base(const GDesc& d, const Unit& u, size_t tstepA) { return (size_t)u.pm * tstepA + (d.amode == 1 ? (size_t)u.pn * 512 : (size_t)0); }
__device__ __forceinline__ size_t a_koff(const GDesc& d, int kt) { return d.amode == 2 ? (size_t)(kt >> 1) * 384 + (size_t)(kt & 1) * 128 : (size_t)kt * 128; }

__device__ __forceinline__ void run_epi(const GDesc& d, const f32x4 (&acc)[2][2][4][2], const Unit& u, int wr, int wc, int fr, int fq) {
    const int epi = d.epi;
    const int row0 = u.pm * BM + wr * 64 + fr, col0 = u.pn * BM + wc * 32 + 8 * fq;
    if (epi == 0) {
        float rsv[2][4];
#pragma unroll
        for (int ai = 0; ai < 2; ++ai)
#pragma unroll
            for (int m = 0; m < 4; ++m) rsv[ai][m] = d.ss ? d.ss[row0 + ai * HALF + m * 16] : 0.f;
#pragma unroll
        for (int ai = 0; ai < 2; ++ai)
#pragma unroll
            for (int m = 0; m < 4; ++m) {
                const int row = row0 + ai * HALF + m * 16;
                const float rs = d.ss ? __builtin_amdgcn_rsqf(rsv[ai][m] * (1.0f / DM) + EPS) : 1.f;
#pragma unroll
                for (int bj = 0; bj < 2; ++bj) {
                    const f32x4 v0 = acc[ai][bj][m][0], v1 = acc[ai][bj][m][1];
                    float v[8] = {v0[0], v0[1], v0[2], v0[3], v1[0], v1[1], v1[2], v1[3]};
#pragma unroll
                    for (int i = 0; i < 8; ++i) { float x = v[i] * rs;
                        if (d.act == 1) x = __builtin_amdgcn_rcpf(1.f + __builtin_amdgcn_exp2f(-1.4426950408889634f * x));
                        else if (d.act == 2) { x = fmaxf(x, 0.f); x = x * x; }
                        v[i] = x; }
                    u32x4 w; w.x = cvt_pk_bf16(v[0], v[1]); w.y = cvt_pk_bf16(v[2], v[3]); w.z = cvt_pk_bf16(v[4], v[5]); w.w = cvt_pk_bf16(v[6], v[7]);
                    *(u32x4*)(d.O + (size_t)row * d.ldc + col0 + bj * HALF) = w;
                }
            }
    } else if (epi == 1) {
#pragma unroll
        for (int ai = 0; ai < 2; ++ai)
#pragma unroll
            for (int m = 0; m < 4; ++m) {
                const int row = row0 + ai * HALF + m * 16;
#pragma unroll
                for (int bj = 0; bj < 2; ++bj) {
                    const f32x4 v0 = acc[ai][bj][m][0], v1 = acc[ai][bj][m][1];
                    u32x4 w; w.x = cvt_pk_bf16(v0[0], v0[1]); w.y = cvt_pk_bf16(v0[2], v0[3]); w.z = cvt_pk_bf16(v1[0], v1[1]); w.w = cvt_pk_bf16(v1[2], v1[3]);
                    const int c = wc * 32 + 8 * fq;
                    bf16_t* p = bj == 0 ? (bf16_t*)(d.ws + OFF_KF) + (size_t)row * 3072 + u.pn * 192 + c : (bf16_t*)(d.ws + OFF_V) + (size_t)row * 2048 + u.pn * 128 + c;
                    *(u32x4*)p = w;
                }
            }
    } else if (epi == 2) {
#pragma unroll
        for (int ai = 0; ai < 2; ++ai) {
            u32x4 g[4][2], o[4][2];
#pragma unroll
            for (int m = 0; m < 4; ++m)
#pragma unroll
                for (int bj = 0; bj < 2; ++bj) {
                    const int row = row0 + ai * HALF + m * 16, col = col0 + bj * HALF;
                    g[m][bj] = *(const u32x4*)(d.Gt + (size_t)row * NG + col);
                    o[m][bj] = d.first ? (u32x4){0u, 0u, 0u, 0u} : *(const u32x4*)(d.O + (size_t)row * d.ldc + col);
                }
#pragma unroll
            for (int m = 0; m < 4; ++m)
#pragma unroll
                for (int bj = 0; bj < 2; ++bj) {
                    const int row = row0 + ai * HALF + m * 16, col = col0 + bj * HALF;
                    const f32x4 v0 = acc[ai][bj][m][0], v1 = acc[ai][bj][m][1]; const u32x4 gg = g[m][bj], oo = o[m][bj];
                    u32x4 w;
                    w.x = cvt_pk_bf16(v0[0] * bflo(gg.x) + bflo(oo.x), v0[1] * bfhi(gg.x) + bfhi(oo.x)); w.y = cvt_pk_bf16(v0[2] * bflo(gg.y) + bflo(oo.y), v0[3] * bfhi(gg.y) + bfhi(oo.y));
                    w.z = cvt_pk_bf16(v1[0] * bflo(gg.z) + bflo(oo.z), v1[1] * bfhi(gg.z) + bfhi(oo.z)); w.w = cvt_pk_bf16(v1[2] * bflo(gg.w) + bflo(oo.w), v1[3] * bfhi(gg.w) + bfhi(oo.w));
                    *(u32x4*)(d.O + (size_t)row * d.ldc + col) = w;
                }
        }
    } else {
        bf16_t* XBp = (bf16_t*)(d.ws + OFF_XB);
#pragma unroll
        for (int ai = 0; ai < 2; ++ai) {
            u32x4 xo[4][2];
#pragma unroll
            for (int m = 0; m < 4; ++m)
#pragma unroll
                for (int bj = 0; bj < 2; ++bj) xo[m][bj] = *(const u32x4*)(XBp + (size_t)(row0 + ai * HALF + m * 16) * DM + col0 + bj * HALF);
#pragma unroll
            for (int m = 0; m < 4; ++m) {
                const int row = row0 + ai * HALF + m * 16; float sq = 0.f;
#pragma unroll
                for (int bj = 0; bj < 2; ++bj) {
                    const int col = col0 + bj * HALF; const u32x4 xx = xo[m][bj];
                    const f32x4 v0 = acc[ai][bj][m][0], v1 = acc[ai][bj][m][1];
                    const f32x4 a0 = (f32x4){bflo(xx.x) + v0[0], bfhi(xx.x) + v0[1], bflo(xx.y) + v0[2], bfhi(xx.y) + v0[3]};
                    const f32x4 a1 = (f32x4){bflo(xx.z) + v1[0], bfhi(xx.z) + v1[1], bflo(xx.w) + v1[2], bfhi(xx.w) + v1[3]};
                    if (d.lastout) { float* dp = d.dst + (size_t)row * DM + col; *(f32x4*)dp = a0; *(f32x4*)(dp + 4) = a1; }
                    else { u32x4 w; w.x = cvt_pk_bf16(a0[0], a0[1]); w.y = cvt_pk_bf16(a0[2], a0[3]); w.z = cvt_pk_bf16(a1[0], a1[1]); w.w = cvt_pk_bf16(a1[2], a1[3]);
                        *(u32x4*)(XBp + (size_t)row * DM + col) = w; }
                    sq += (a0[0] * a0[0] + a0[1] * a0[1]) + (a0[2] * a0[2] + a0[3] * a0[3]) + (a1[0] * a1[0] + a1[1] * a1[1]) + (a1[2] * a1[2] + a1[3] * a1[3]);
                }
                if (d.ssacc) { sq += __shfl_xor(sq, 16); sq += __shfl_xor(sq, 32); if (fq == 0) atomicAdd(d.ssacc + row, sq); }
            }
        }
    }
}

__device__ __forceinline__ void skinny_gemm(LAS unsigned char* lds, const GDesc& d, int G, int bx) {
    const int tid = opaque_tid(), wid = __builtin_amdgcn_readfirstlane(tid >> 6), lane = tid & 63, fr = lane & 15, fq = lane >> 4;
    const int ntask = d.nN * 16, steps = d.nt >> 2;
    LAS f32x4* red = (LAS f32x4*)lds;
    const int rem = ((MREAL / 256) * d.nN) % G;
    for (int t = (bx >= rem ? bx - rem : bx - rem + G); t < ntask; t += G) {
        const int n0 = t * 16;
        const char* arow = d.A + (size_t)(MREAL + fr) * d.lda * 2 + (d.amode == 1 ? (size_t)(n0 >> 8) * 512 : (size_t)0);
        const char* brow = d.Bt + (size_t)(n0 + fr) * d.ldb * 2;
        f32x4 acc = (f32x4){0.f, 0.f, 0.f, 0.f};
        const int kbeg = wid * steps * 32 + fq * 8;
#pragma unroll 8
        for (int st = 0; st < steps; ++st) {
            const int k = kbeg + st * 32;
            const int ka = d.amode == 2 ? (k >> 7) * 192 + (k & 127) : k;
            const bf16x8 a = *(const bf16x8*)(arow + (size_t)ka * 2); const bf16x8 b = *(const bf16x8*)(brow + (size_t)k * 2);
            acc = __builtin_amdgcn_mfma_f32_16x16x32_bf16(b, a, acc, 0, 0, 0);
        }
        red[wid * 64 + lane] = acc;
        __syncthreads();
        if (wid == 0) {
            f32x4 v = red[lane];
#pragma unroll
            for (int w_ = 1; w_ < 8; ++w_) v += red[w_ * 64 + lane];
            const int row = MREAL + fr, col = n0 + 4 * fq, epi = d.epi;
            if (epi == 0) {
                const float rs = d.ss ? __builtin_amdgcn_rsqf(d.ss[row] * (1.0f / DM) + EPS) : 1.f;
#pragma unroll
                for (int i = 0; i < 4; ++i) { float x = v[i] * rs;
                    if (d.act == 1) x = __builtin_amdgcn_rcpf(1.f + __builtin_amdgcn_exp2f(-1.4426950408889634f * x));
                    else if (d.act == 2) { x = fmaxf(x, 0.f); x = x * x; }
                    v[i] = x; }
                u32x2 w; w.x = cvt_pk_bf16(v[0], v[1]); w.y = cvt_pk_bf16(v[2], v[3]);
                *(u32x2*)(d.O + (size_t)row * d.ldc + col) = w;
            } else if (epi == 1) {
                const int h = col >> 8, c = col & 255;
                bf16_t* p = c < 128 ? (bf16_t*)(d.ws + OFF_KF) + (size_t)row * 3072 + h * 192 + c : (bf16_t*)(d.ws + OFF_V) + (size_t)row * 2048 + h * 128 + (c - 128);
                u32x2 w; w.x = cvt_pk_bf16(v[0], v[1]); w.y = cvt_pk_bf16(v[2], v[3]);
                *(u32x2*)p = w;
            } else if (epi == 2) {
                const u32x2 g = *(const u32x2*)(d.Gt + (size_t)row * NG + col);
                v[0] *= bflo(g.x); v[1] *= bfhi(g.x); v[2] *= bflo(g.y); v[3] *= bfhi(g.y);
                bf16_t* p = d.O + (size_t)row * d.ldc + col;
                if (!d.first) { const u32x2 o = *(const u32x2*)p; v[0] += bflo(o.x); v[1] += bfhi(o.x); v[2] += bflo(o.y); v[3] += bfhi(o.y); }
                u32x2 w; w.x = cvt_pk_bf16(v[0], v[1]); w.y = cvt_pk_bf16(v[2], v[3]);
                *(u32x2*)p = w;
            } else {
                float* xp = (float*)(d.ws + OFF_XM) + (size_t)fr * DM + col;
                const f32x4 a0 = *(const f32x4*)xp + v;
                *(f32x4*)xp = a0;
                u32x2 w; w.x = cvt_pk_bf16(a0[0], a0[1]); w.y = cvt_pk_bf16(a0[2], a0[3]);
                *(u32x2*)((bf16_t*)(d.ws + OFF_XB) + (size_t)row * DM + col) = w;
                float sq = (a0[0] * a0[0] + a0[1] * a0[1]) + (a0[2] * a0[2] + a0[3] * a0[3]);
                sq += __shfl_xor(sq, 16); sq += __shfl_xor(sq, 32);
                if (fq == 0 && d.ssacc) atomicAdd(d.ssacc + row, sq);
            }
        }
        __syncthreads();
    }
}

__device__ __forceinline__ void gemm_generic(LAS unsigned char* lds, const GDesc& d, int G, int bx) {
    StaticOrder S; S.init(MREAL / 256, d.nN, G, bx);
    const int tid = opaque_tid(), wid = __builtin_amdgcn_readfirstlane(tid >> 6), lane = tid & 63, wr = wid >> 2, wc = wid & 3, fr = lane & 15, fq = lane >> 4;
    const int nt = d.nt;
    unsigned voffA[2], voffB[2];
#pragma unroll
    for (int i = 0; i < 2; ++i) { int R, C; stage_rc(tid * 16 + i * 8192, R, C); const int Rb = (R & ~31) + perm32(R & 31);
        voffA[i] = (unsigned)(R * d.lda + C) * 2u; voffB[i] = (unsigned)(Rb * d.ldb + C) * 2u; }
    const size_t kstep = (size_t)(BK * 2);
    const size_t hstepA = (size_t)HALF * d.lda * 2, hstepB = (size_t)HALF * d.ldb * 2, tstepB = 2 * hstepB, tstepA = 2 * hstepA;
    const unsigned ldsw = (unsigned)wid * 1024u;
    const int aoff = lds_byte(wr * 64 + fr, fq * 8), boff = lds_byte(wc * 32 + fr, fq * 8);
#define PG8_SA(b, h) (((b) * 2 + (h)) * HTB)
#define PG8_SB(b, h) ((4 + (b) * 2 + (h)) * HTB)
#define PG8_STAGE(bufoff, gbase, voff) do { _Pragma("unroll") for (int _i = 0; _i < 2; ++_i) \
        __builtin_amdgcn_global_load_lds((const unsigned*)((const char*)(gbase) + (voff)[_i]), (LAS unsigned*)(lds + (bufoff) + ldsw + _i * 8192), 16, 0, 0); } while (0)
#define PG8_LDA(dst, b, h) do { _Pragma("unroll") for (int m = 0; m < 4; ++m) _Pragma("unroll") for (int k = 0; k < 2; ++k) dst[m][k] = *(const LAS bf16x8*)(lds + PG8_SA(b, h) + aoff + m * 2048 + k * 1024); } while (0)
#define PG8_LDB(dst, b, h) do { _Pragma("unroll") for (int n = 0; n < 2; ++n) _Pragma("unroll") for (int k = 0; k < 2; ++k) dst[n][k] = *(const LAS bf16x8*)(lds + PG8_SB(b, h) + boff + n * 2048 + k * 1024); } while (0)
#define PG8_MMA(ai, bj, At, Bt) do { __builtin_amdgcn_s_setprio(1); _Pragma("unroll") for (int m = 0; m < 4; ++m) _Pragma("unroll") for (int n = 0; n < 2; ++n) _Pragma("unroll") for (int k = 0; k < 2; ++k) \
        acc[ai][bj][m][n] = __builtin_amdgcn_mfma_f32_16x16x32_bf16(Bt[n][k], At[m][k], acc[ai][bj][m][n], 0, 0, 0); __builtin_amdgcn_s_setprio(0); } while (0)
#define PG8_WAIT_V(n) asm volatile("s_waitcnt vmcnt(" #n ")" ::: "memory")
#define PG8_WAIT_L(n) asm volatile("s_waitcnt lgkmcnt(" #n ")" ::: "memory")
#define PG8_BAR __builtin_amdgcn_s_barrier()
#define PG8_SCHED __builtin_amdgcn_sched_barrier(0)
    Unit cur, nxt; int ui = 0;
    if (!S.next(0, cur)) return;
    f32x4 acc[2][2][4][2];
#pragma unroll
    for (int a = 0; a < 2; ++a)
#pragma unroll
        for (int b = 0; b < 2; ++b)
#pragma unroll
            for (int m = 0; m < 4; ++m)
#pragma unroll
                for (int n = 0; n < 2; ++n) acc[a][b][m][n] = (f32x4){0.f, 0.f, 0.f, 0.f};
    bf16x8 At[4][2], B0[2][2], B1[2][2];
    const char* cA = d.A + a_base(d, cur, tstepA); const char* cB = d.Bt + (size_t)cur.pn * tstepB;
    {
        const char* cA1 = cA + a_koff(d, 1);
        PG8_STAGE(PG8_SB(0, 0), cB, voffB); PG8_STAGE(PG8_SB(0, 1), cB + hstepB, voffB); PG8_STAGE(PG8_SA(0, 0), cA, voffA); PG8_STAGE(PG8_SA(0, 1), cA + hstepA, voffA);
        if (wr == 1) PG8_BAR;
        PG8_WAIT_V(2); PG8_BAR;
        PG8_STAGE(PG8_SB(1, 0), cB + kstep, voffB); PG8_STAGE(PG8_SA(1, 0), cA1, voffA); PG8_STAGE(PG8_SB(1, 1), cB + hstepB + kstep, voffB);
        PG8_WAIT_V(6); PG8_BAR;
    }
    for (;;) {
        const bool has_next = S.next(ui + 1, nxt);
        const char* nA = has_next ? d.A + a_base(d, nxt, tstepA) : cA; const char* nB = has_next ? d.Bt + (size_t)nxt.pn * tstepB : cB;
        for (int t = 0; t < nt; t += 2) {
            const bool last = (t == nt - 2);
            const char* a1 = cA + a_koff(d, t + 1);
            const char* a2 = last ? nA : cA + a_koff(d, t + 2); const char* b2 = last ? nB : cB + (size_t)(t + 2) * kstep;
            const char* a3 = last ? nA + a_koff(d, 1) : cA + a_koff(d, t + 3); const char* b3 = b2 + kstep;
            PG8_LDB(B0, 0, 0); PG8_LDB(B1, 0, 1); PG8_SCHED; PG8_LDA(At, 0, 0); PG8_STAGE(PG8_SA(1, 1), a1 + hstepA, voffA);
            PG8_WAIT_V(8); PG8_WAIT_L(0); PG8_BAR; PG8_MMA(0, 0, At, B0); PG8_MMA(0, 1, At, B1); PG8_BAR; PG8_SCHED;
            PG8_LDA(At, 0, 1); PG8_STAGE(PG8_SB(0, 0), b2, voffB); PG8_STAGE(PG8_SB(0, 1), b2 + hstepB, voffB); PG8_STAGE(PG8_SA(0, 0), a2, voffA);
            PG8_WAIT_V(8); PG8_WAIT_L(0); PG8_BAR; PG8_MMA(1, 0, At, B0); PG8_MMA(1, 1, At, B1); PG8_BAR; PG8_SCHED;
            PG8_LDB(B0, 1, 0); PG8_LDB(B1, 1, 1); PG8_SCHED; PG8_LDA(At, 1, 0); PG8_STAGE(PG8_SA(0, 1), a2 + hstepA, voffA);
            PG8_WAIT_V(8); PG8_WAIT_L(0); PG8_BAR; PG8_MMA(0, 0, At, B0); PG8_MMA(0, 1, At, B1); PG8_BAR; PG8_SCHED;
            PG8_LDA(At, 1, 1); PG8_STAGE(PG8_SB(1, 0), b3, voffB); PG8_STAGE(PG8_SB(1, 1), b3 + hstepB, voffB); PG8_STAGE(PG8_SA(1, 0), a3, voffA);
            PG8_WAIT_V(8); PG8_WAIT_L(0); PG8_BAR; PG8_MMA(1, 0, At, B0); PG8_MMA(1, 1, At, B1); PG8_BAR; PG8_SCHED;
        }
        if (wr == 0) PG8_BAR;
        run_epi(d, acc, cur, wr, wc, fr, fq);
        if (!has_next) break;
#pragma unroll
        for (int a = 0; a < 2; ++a)
#pragma unroll
            for (int b = 0; b < 2; ++b)
#pragma unroll
                for (int m = 0; m < 4; ++m)
#pragma unroll
                    for (int n = 0; n < 2; ++n) acc[a][b][m][n] = (f32x4){0.f, 0.f, 0.f, 0.f};
        cur = nxt; cA = nA; cB = nB; ++ui;
        if (wr == 1) PG8_BAR;
    }
    PG8_WAIT_V(0);
    PG8_BAR;
#undef PG8_SA
#undef PG8_SB
#undef PG8_STAGE
#undef PG8_LDA
#undef PG8_LDB
#undef PG8_MMA
#undef PG8_WAIT_V
#undef PG8_WAIT_L
#undef PG8_BAR
#undef PG8_SCHED
}
}

namespace att {
constexpr int NW = 8, QBLK = 32, KVBLK = 64, QB = 256, NKT = 65;
constexpr int KROW = 400;
constexpr int SHM_V = 64 * 128 * 2, SHM_K = 64 * KROW;
constexpr int LDS_QR = 2 * SHM_V + 2 * SHM_K + NW * 64 * 4, QR_ROW = 272, QR_WAVE = 32 * QR_ROW;
constexpr int LDS_NEED = LDS_QR + NW * QR_WAVE;
constexpr float SCALE = 0.07216878364870323f;
constexpr float THR = 8.f;
#define KSWZ(row, colB) ((row) * KROW + (colB))
#define SBAR() __builtin_amdgcn_sched_barrier(0)
__device__ __forceinline__ int v_st(int k, int c) { const int kk = (k & ~0xC) | ((k & 4) << 1) | ((k & 8) >> 1); return ((kk >> 3) * 4 + (c >> 5)) * 512 + ((kk & 7) * 32 + (c & 31)) * 2; }
__device__ __forceinline__ int v_rd_base(int lane) { return ((lane & 3) << 3) | (((lane >> 2) & 3) << 6) | (((lane >> 4) & 1) << 5) | (((lane >> 5) & 1) << 8); }
constexpr int v_rd_off(int d0, int ks, int half) { return d0 * 512 + ks * 4096 + half * 2048; }
__device__ __forceinline__ int crow(int r, int hi) { return (r & 3) + 8 * (r >> 2) + 4 * hi; }
__device__ __forceinline__ bf16x8 ld8(const bf16_t* p) { return *reinterpret_cast<const bf16x8*>(p); }

__device__ __forceinline__ void mask_tile(f32x16& p0, f32x16& p1, int dq) {
    const float NEG = -__builtin_inff();
#pragma unroll
    for (int r = 0; r < 16; ++r) {
        const int c = (r & 3) + 8 * (r >> 2);
        if (dq - c < 0) p0[r] = NEG;
        if (dq - c - 32 < 0) p1[r] = NEG;
    }
}
__device__ __forceinline__ void partialSM(f32x16& p0, f32x16& p1, float& m_reg, float& mn, float& alpha) {
    float pmax = p0[0];
#pragma unroll
    for (int r = 1; r < 16; ++r) pmax = fmaxf(pmax, p0[r]);
#pragma unroll
    for (int r = 0; r < 16; ++r) pmax = fmaxf(pmax, p1[r]);
    { auto rr = __builtin_amdgcn_permlane32_swap(__float_as_uint(pmax), __float_as_uint(pmax), false, false);
      pmax = fmaxf(__uint_as_float(rr[0]), __uint_as_float(rr[1])); }
    constexpr float C2 = 1.4426950408889634f * SCALE;
    if (__builtin_expect(__all((pmax - m_reg) * SCALE <= THR), 1)) { mn = m_reg; alpha = 1.f; }
    else { mn = fmaxf(m_reg, pmax); alpha = __builtin_amdgcn_exp2f((m_reg - mn) * C2); m_reg = mn; }
    const float mnL = -mn * C2;
#pragma unroll
    for (int r = 0; r < 16; ++r) p0[r] = fmaf(p0[r], C2, mnL);
#pragma unroll
    for (int r = 0; r < 16; ++r) p1[r] = fmaf(p1[r], C2, mnL);
#pragma unroll
    for (int r = 0; r < 16; ++r) p0[r] = __builtin_amdgcn_exp2f(p0[r]);
}
__device__ __forceinline__ void finishSM(f32x16& p0, f32x16& p1, float alpha, float& l_reg, bf16x8& pa0, bf16x8& pa1, bf16x8& pa2, bf16x8& pa3) {
#pragma unroll
    for (int r = 0; r < 16; ++r) p1[r] = __builtin_amdgcn_exp2f(p1[r]);
    float ps = 0;
#pragma unroll
    for (int r = 0; r < 16; ++r) ps += p0[r];
#pragma unroll
    for (int r = 0; r < 16; ++r) ps += p1[r];
    { auto rr = __builtin_amdgcn_permlane32_swap(__float_as_uint(ps), __float_as_uint(ps), false, false);
      ps = __uint_as_float(rr[0]) + __uint_as_float(rr[1]); }
    l_reg = l_reg * alpha + ps;
#define PK4(P, B_, OUT) do { unsigned a0 = cvt_pk_bf16(P[B_+0], P[B_+1]), a1 = cvt_pk_bf16(P[B_+2], P[B_+3]);                          \
        unsigned b0 = cvt_pk_bf16(P[B_+4], P[B_+5]), b1 = cvt_pk_bf16(P[B_+6], P[B_+7]);                                             \
        auto r0 = __builtin_amdgcn_permlane32_swap(a0, b0, false, false); auto r1 = __builtin_amdgcn_permlane32_swap(a1, b1, false, false); \
        u32x4 w = {r0[0], r1[0], r0[1], r1[1]}; OUT = *reinterpret_cast<bf16x8*>(&w); } while (0)
    PK4(p0, 0, pa0); PK4(p0, 8, pa1); PK4(p1, 0, pa2); PK4(p1, 8, pa3);
#undef PK4
}
template <int KB>
__device__ __forceinline__ void qkt(f32x16& p0, f32x16& p1, const char* K_lds, int r32, int hi, const bf16x8* qr, const char* qbase) {
    p0 = f32x16{}; p1 = f32x16{};
    const char* kbp = K_lds + KB * SHM_K + r32 * KROW + hi * 16;
#pragma unroll
    for (int d0 = 0; d0 < 12; ++d0) { const char* a = kbp + d0 * 32;
        bf16x8 b0 = *reinterpret_cast<const bf16x8*>(a);
        bf16x8 b1 = *reinterpret_cast<const bf16x8*>(a + 32 * KROW);
        const bf16x8 qf = d0 < 4 ? qr[d0 & 3] : *reinterpret_cast<const bf16x8*>(qbase + (d0 - 4) * 32);
        p0 = __builtin_amdgcn_mfma_f32_32x32x16_bf16(b0, qf, p0, 0, 0, 0);
        p1 = __builtin_amdgcn_mfma_f32_32x32x16_bf16(b1, qf, p1, 0, 0, 0); }
}
template <int VB>
__device__ __forceinline__ void pv_tile(f32x16* o, int vb0, bf16x8 pa0, bf16x8 pa1, bf16x8 pa2, bf16x8 pa3) {
#define TRRD(dst, off) asm volatile("ds_read_b64_tr_b16 %0, %1 offset:%2" : "=&v"(dst) : "v"(vb0), "i"(off) : "memory")
#define PV_D0(d0) do { s16x4 l0, l1, l2, l3, h0, h1, h2, h3; constexpr int b_ = VB * SHM_V + v_rd_off(d0, 0, 0); \
        TRRD(l0, b_); TRRD(h0, b_ + 2048); TRRD(l1, b_ + 4096); TRRD(h1, b_ + 6144); TRRD(l2, b_ + 8192); TRRD(h2, b_ + 10240); TRRD(l3, b_ + 12288); TRRD(h3, b_ + 14336); \
        asm volatile("s_waitcnt lgkmcnt(0)" ::: "memory"); SBAR();   \
        o[d0] = __builtin_amdgcn_mfma_f32_32x32x16_bf16(pa0, (bf16x8){l0[0], l0[1], l0[2], l0[3], h0[0], h0[1], h0[2], h0[3]}, o[d0], 0, 0, 0);   \
        o[d0] = __builtin_amdgcn_mfma_f32_32x32x16_bf16(pa1, (bf16x8){l1[0], l1[1], l1[2], l1[3], h1[0], h1[1], h1[2], h1[3]}, o[d0], 0, 0, 0);   \
        o[d0] = __builtin_amdgcn_mfma_f32_32x32x16_bf16(pa2, (bf16x8){l2[0], l2[1], l2[2], l2[3], h2[0], h2[1], h2[2], h2[3]}, o[d0], 0, 0, 0);   \
        o[d0] = __builtin_amdgcn_mfma_f32_32x32x16_bf16(pa3, (bf16x8){l3[0], l3[1], l3[2], l3[3], h3[0], h3[1], h3[2], h3[3]}, o[d0], 0, 0, 0); } while (0)
    PV_D0(0); PV_D0(1); PV_D0(2); PV_D0(3);
#undef PV_D0
#undef TRRD
}
static_assert(LDS_NEED <= 155648, "attention LDS");
struct Ref { int b, h, P0; };
struct Tens { unsigned char* ws; };
struct Seam { bf16x8 qr[12]; bf16x8 st_v0, st_v1, st_k0, st_k1, st_k2; };
#define VMW() asm volatile("s_waitcnt vmcnt(0)" ::: "memory")
#define VMWN(n) asm volatile("s_waitcnt vmcnt(%0)" :: "i"(n) : "memory")
#define SLOAD(R_, k0) do { const size_t tr_ = (size_t)tokrow((R_).b, (k0) + srow); const bf16_t* kp_ = (const bf16_t*)(T.ws + OFF_KF) + tr_ * 3072 + (R_).h * 192 + c0 * 8; const bf16_t* vp_ = (const bf16_t*)(T.ws + OFF_V) + tr_ * 2048 + (R_).h * 128 + c0 * 8; \
        S.st_v0 = ld8(vp_); S.st_v1 = ld8(vp_ + 64); S.st_k0 = ld8(kp_); S.st_k1 = ld8(kp_ + 64); S.st_k2 = ld8(kp_ + 128); } while (0)
#define SWRITE_HK(bf) do { *(bf16x8*)(K_lds + (bf) * SHM_K + kws) = S.st_k0; *(bf16x8*)(K_lds + (bf) * SHM_K + kws + 128) = S.st_k1; *(bf16x8*)(K_lds + (bf) * SHM_K + kws + 256) = S.st_k2; } while (0)
#define SWRITE_HV(bf) do { *(bf16x8*)(V_lds + (bf) * SHM_V + vst0) = S.st_v0; *(bf16x8*)(V_lds + (bf) * SHM_V + vst0 + 1024) = S.st_v1; } while (0)
#define SWRITE_H(bf) do { SWRITE_HV(bf); SWRITE_HK(bf); } while (0)
#define QLOAD(R_) do { const size_t qrow_ = (size_t)tokrow((R_).b, (R_).P0 + wid * QBLK + r32); const bf16_t* qp_ = (const bf16_t*)(T.ws + OFF_Q) + qrow_ * 3072 + (R_).h * 192 + hi * 8; \
        _Pragma("unroll") for (int d0 = 0; d0 < 12; ++d0) S.qr[d0] = ld8(qp_ + d0 * 16); } while (0)

__device__ __forceinline__ void attn_prime(const Ref& cur, const Tens& T, char* lds, Seam& S) {
    const int tid = opaque_tid(), wid = __builtin_amdgcn_readfirstlane(tid >> 6), lane = tid & 63, r32 = lane & 31, hi = lane >> 5;
    const int srow = tid >> 3, c0 = tid & 7, kws = KSWZ(srow, c0 * 16); char* K_lds = lds + 2 * SHM_V;
    QLOAD(cur);
    SLOAD(cur, 0); VMW(); SWRITE_HK(0);
    __syncthreads();
}
__device__ __forceinline__ void attn_block(const Ref& cur, const Ref& nxt, const Tens& T, char* lds, Seam& S, bool nostore) {
    const int tid = opaque_tid(), wid = __builtin_amdgcn_readfirstlane(tid >> 6), lane = tid & 63, r32 = lane & 31, hi = lane >> 5;
    int j_hi = (cur.P0 + QB - 1) / KVBLK + 1; if (j_hi > NKT) j_hi = NKT;
    if (cur.P0 == 0) j_hi = 1;
    const int NT = j_hi;
    const int qlo = cur.P0 + wid * QBLK, qm = qlo + r32 - 4 * hi;
    char* V_lds = lds; char* K_lds = lds + 2 * SHM_V;
    float* ws = (float*)(lds + 2 * SHM_V + 2 * SHM_K) + wid * 64; float* li_l = ws, * al_l = ws + 32;
    float m_reg = -1e30f, l_reg = 0; f32x16 o[4] = {};
    const int srow = tid >> 3, c0 = tid & 7, vst0 = v_st(srow, c0 * 8), kws = KSWZ(srow, c0 * 16);
    const int vb0 = (int)(uintptr_t)V_lds + v_rd_base(lane);
#define RESC(a) do { if (__any((a) < 1.f)) { if (hi == 0) al_l[r32] = (a); asm volatile("s_waitcnt lgkmcnt(0)" ::: "memory");              \
                     _Pragma("unroll") for (int d_ = 0; d_ < 4; ++d_) _Pragma("unroll") for (int r = 0; r < 16; ++r) o[d_][r] *= al_l[crow(r, hi)]; } } while (0)
#define KBASE(t) ((t) * KVBLK)
#define MASKT(P0_, P1_, t) do { const int kb_ = KBASE(t); if (kb_ + KVBLK - 1 > qlo) mask_tile(P0_, P1_, qm - kb_); } while (0)
    f32x16 pA0, pA1, pB0, pB1; float mnA, mnB, alA, alB; bf16x8 pa0, pa1, pa2, pa3;
    char* qbase = lds + LDS_QR + wid * QR_WAVE + r32 * QR_ROW + hi * 16;
#pragma unroll
    for (int j = 0; j < 8; ++j) *(bf16x8*)(qbase + j * 32) = S.qr[4 + j];
    SBAR();
    SWRITE_HV(0); SBAR();
    if (NT > 1) { SLOAD(cur, KBASE(1)); }
    SBAR(); qkt<0>(pA0, pA1, K_lds, r32, hi, S.qr, qbase);
    MASKT(pA0, pA1, 0); partialSM(pA0, pA1, m_reg, mnA, alA);
    if (NT > 1) { VMW(); SWRITE_H(1); }
    __syncthreads();
#define HALF_STEP(PX0, PX1, mnX, alX, PY0, PY1, alY, t, KB, VB, SB) do {                                                      \
        SBAR(); qkt<KB>(PX0, PX1, K_lds, r32, hi, S.qr, qbase);                                                                      \
        finishSM(PY0, PY1, alY, l_reg, pa0, pa1, pa2, pa3); SBAR();                                                           \
        if ((t) + 1 < NT) { SLOAD(cur, KBASE((t) + 1)); SBAR(); }                                                             \
        pv_tile<VB>(o, vb0, pa0, pa1, pa2, pa3); MASKT(PX0, PX1, (t)); partialSM(PX0, PX1, m_reg, mnX, alX);                  \
        __syncthreads();                                                                                                      \
        if ((t) + 1 < NT) { VMW(); SWRITE_H(SB); }                                                                            \
        RESC(alX); __syncthreads(); } while (0)
    for (int t = 1; t + 1 < NT; t += 2) {
        HALF_STEP(pB0, pB1, mnB, alB, pA0, pA1, alA, t, 1, 0, 0);
        HALF_STEP(pA0, pA1, mnA, alA, pB0, pB1, alB, t + 1, 0, 1, 1);
    }
    const bool even = (NT & 1) == 0;
    if (even) { SBAR(); qkt<1>(pB0, pB1, K_lds, r32, hi, S.qr, qbase); SBAR(); }
    SLOAD(nxt, 0); SBAR();
    QLOAD(nxt);
    SBAR();
    finishSM(pA0, pA1, alA, l_reg, pa0, pa1, pa2, pa3); SBAR();
    pv_tile<0>(o, vb0, pa0, pa1, pa2, pa3);
    if (even) { MASKT(pB0, pB1, NT - 1); partialSM(pB0, pB1, m_reg, mnB, alB); __syncthreads(); RESC(alB);
        finishSM(pB0, pB1, alB, l_reg, pa0, pa1, pa2, pa3); SBAR(); pv_tile<1>(o, vb0, pa0, pa1, pa2, pa3); }
    SBAR(); VMWN(12); SWRITE_HK(0); SBAR();
    if (hi == 0) li_l[r32] = l_reg; asm volatile("s_waitcnt lgkmcnt(0)" ::: "memory");
    float rli[16];
#pragma unroll
    for (int r = 0; r < 16; ++r) rli[r] = __builtin_amdgcn_rcpf(li_l[crow(r, hi)]);
    {
        char* stg = lds + LDS_QR + wid * QR_WAVE;
#pragma unroll
        for (int r = 0; r < 16; ++r) { const int orow = crow(r, hi);
#pragma unroll
            for (int d0 = 0; d0 < 4; ++d0) { const float v = o[d0][r] * rli[r];
                *(bf16_t*)(stg + orow * QR_ROW + (d0 * 32 + r32) * 2) = (bf16_t)(cvt_pk_bf16(v, 0.f) & 0xffffu); } }
        asm volatile("s_waitcnt lgkmcnt(0)" ::: "memory");
#pragma unroll
        for (int i = 0; i < 8; ++i) { const int row = i * 4 + (lane >> 4), ch = lane & 15; const int pos = cur.P0 + wid * QBLK + row;
            const u32x4 w = *(const u32x4*)(stg + row * QR_ROW + ch * 16);
            const bool ok = (cur.P0 != 0 || pos < NMETA) && !nostore;
            if (ok) *(u32x4*)((bf16_t*)(T.ws + OFF_Q) + (size_t)tokrow(cur.b, pos) * 3072 + cur.h * 192 + ch * 8) = w; }
        asm volatile("s_waitcnt lgkmcnt(0)" ::: "memory");
    }
    __syncthreads();
#undef RESC
#undef KBASE
#undef MASKT
#undef HALF_STEP
}
__device__ __forceinline__ Ref make_ref(int L, int pass) {
    Ref r;
    if (L < 512) { const int bh = L >> 3, x = L & 7; const int qb = pass ? 15 - x : x; r.b = bh >> 4; r.h = bh & 15; r.P0 = NMETA + qb * QB; }
    else { r.b = 0; r.h = L - 512; r.P0 = 0; }
    return r;
}
__device__ __forceinline__ void attn_phase(char* lds, const Tens& T, int vcu, int G, bool nostore, bool with_meta) {
    const int TOTAL = with_meta ? 512 + 16 : 512;
    int L = vcu; if (L >= TOTAL) return;
    int pass = 0;
    Ref cur = make_ref(L, 0);
    Seam S;
    attn_prime(cur, T, lds, S);
    for (;;) {
        const bool more_pass = (pass == 0 && L < 512), more_item = L + G < TOTAL, last = !more_pass && !more_item;
        int passn = pass + 1, Ln = L;
        if (!more_pass) { passn = 0; Ln = more_item ? L + G : L; }
        const Ref nxt = last ? cur : make_ref(Ln, passn);
        attn_block(cur, nxt, T, lds, S, nostore);
        if (last) break;
        cur = nxt; pass = passn; L = Ln;
    }
}
#undef SLOAD
#undef SWRITE_HK
#undef SWRITE_HV
#undef SWRITE_H
#undef QLOAD
#undef VMW
#undef VMWN
#undef SBAR
}

struct Params {
    const float* x; const float* meta; const float* attn_norm; const float* w_in; const float* conv_w; const float* q_lat_norm; const float* kv_lat_norm;
    const float* w_uq; const float* w_ukv; const float* q_norm; const float* k_norm; const float* pool_w; const float* pool_scale;
    const float* w_a; const float* w_b; const float* w_c; const float* w_o; const float* mlp_norm; const float* w_up; const float* w_down;
    float* out; unsigned char* ws;
};

struct MatDesc { const float* W; int ldw, K, N; bf16_t* WT; const float* gain; const float* colscale; int split; int splitadd; };
__device__ __forceinline__ void convert_mat(const MatDesc& m, LAS float* scr, int gw, int NGW, int lane, int& base) {
    const int nblk = m.N / 64, items = (m.K / 64) * nblk;
    int it = gw - (base % NGW); if (it < 0) it += NGW;
    base += items;
    if (it >= items) return;
    const int cl = (lane & 15) * 4, kr = lane >> 4, c = lane & 7;
    f32x4 v[16]; float g[16]; f32x4 cs4;
#define CV_LOAD(it_) do { const int kb_ = (it_) / nblk, n0_ = ((it_) % nblk) * 64, k0_ = kb_ * 64; \
        cs4 = m.colscale ? *(const f32x4*)(m.colscale + n0_ + cl) : (f32x4){1.f, 1.f, 1.f, 1.f}; \
        _Pragma("unroll") for (int i = 0; i < 16; ++i) v[i] = __builtin_nontemporal_load((const f32x4*)(m.W + (size_t)(k0_ + i * 4 + kr) * m.ldw + n0_ + cl)); \
        _Pragma("unroll") for (int i = 0; i < 16; ++i) g[i] = m.gain ? m.gain[k0_ + i * 4 + kr] : 1.f; } while (0)
    CV_LOAD(it);
    for (;;) {
        const int kb = it / nblk, n0 = (it % nblk) * 64, k0 = kb * 64;
        const int dst_row = n0 >= m.split ? n0 + m.splitadd : n0;
#pragma unroll
        for (int i = 0; i < 16; ++i) { const int kk = i * 4 + kr; const f32x4 x = v[i] * cs4 * g[i];
            LAS float* dl = scr + kk * 65 + cl; dl[0] = x[0]; dl[1] = x[1]; dl[2] = x[2]; dl[3] = x[3]; }
        asm volatile("s_waitcnt lgkmcnt(0)" ::: "memory");
        const int nit = it + NGW; const bool more = nit < items;
        if (more) CV_LOAD(nit);
#pragma unroll
        for (int j = 0; j < 8; ++j) { const int n = (lane >> 3) + 8 * j; const LAS float* sl = scr + (8 * c) * 65 + n;
            u32x4 o; o.x = cvt_pk_bf16(sl[0 * 65], sl[1 * 65]); o.y = cvt_pk_bf16(sl[2 * 65], sl[3 * 65]); o.z = cvt_pk_bf16(sl[4 * 65], sl[5 * 65]); o.w = cvt_pk_bf16(sl[6 * 65], sl[7 * 65]);
            *(u32x4*)(m.WT + (size_t)(dst_row + n) * m.K + k0 + 8 * c) = o; }
        asm volatile("s_waitcnt lgkmcnt(0)" ::: "memory");
        if (!more) break;
        it = nit;
    }
#undef CV_LOAD
}
__device__ __forceinline__ void convert_weights(const Params& P, int l, LAS unsigned char* lds, int gw, int NGW, int wave, int lane) {
    LAS float* scr = (LAS float*)(lds + wave * 16640);
    unsigned char* ws = P.ws; int base = 0;
    const int BIG = 1 << 30;
    MatDesc m;
    m = MatDesc{P.w_in + (size_t)l * DM * DIN, DIN, DM, DIN, (bf16_t*)(ws + OFF_WIN), P.attn_norm + l * DM, nullptr, N1SRC, N1 - N1SRC}; convert_mat(m, scr, gw, NGW, lane, base);
    m = MatDesc{P.w_uq + (size_t)l * 512 * 3072, 3072, 512, 3072, (bf16_t*)(ws + OFF_WUQ), P.q_lat_norm + l * 512, nullptr, BIG, 0}; convert_mat(m, scr, gw, NGW, lane, base);
    m = MatDesc{P.w_ukv + (size_t)l * 512 * 4096, 4096, 512, 4096, (bf16_t*)(ws + OFF_WUKV), P.kv_lat_norm + l * 512, nullptr, BIG, 0}; convert_mat(m, scr, gw, NGW, lane, base);
    for (int g = 0; g < 4; ++g) {
        m = MatDesc{P.pool_w + (size_t)l * 4 * 65536 + (size_t)g * 65536, 256, 256, 256, (bf16_t*)(ws + OFF_WPOOL) + (size_t)g * 65536, nullptr, P.pool_scale + l * 1024 + g * 256, BIG, 0}; convert_mat(m, scr, gw, NGW, lane, base); }
    m = MatDesc{P.w_a + (size_t)l * 1024 * 2048, 2048, 1024, 2048, (bf16_t*)(ws + OFF_WA), nullptr, nullptr, BIG, 0}; convert_mat(m, scr, gw, NGW, lane, base);
    m = MatDesc{P.w_b + (size_t)l * 2048 * 2048, 2048, 2048, 2048, (bf16_t*)(ws + OFF_WB), nullptr, nullptr, BIG, 0}; convert_mat(m, scr, gw, NGW, lane, base);
    m = MatDesc{P.w_c + (size_t)l * 1024 * 2048, 2048, 1024, 2048, (bf16_t*)(ws + OFF_WC), nullptr, nullptr, BIG, 0}; convert_mat(m, scr, gw, NGW, lane, base);
    m = MatDesc{P.w_o + (size_t)l * 2048 * 2048, 2048, 2048, 2048, (bf16_t*)(ws + OFF_WO), nullptr, nullptr, BIG, 0}; convert_mat(m, scr, gw, NGW, lane, base);
    m = MatDesc{P.w_up + (size_t)l * DM * DFF, DFF, DM, DFF, (bf16_t*)(ws + OFF_WUP), P.mlp_norm + l * DM, nullptr, BIG, 0}; convert_mat(m, scr, gw, NGW, lane, base);
    m = MatDesc{P.w_down + (size_t)l * DFF * DM, DM, DFF, DM, (bf16_t*)(ws + OFF_WDN), nullptr, nullptr, BIG, 0}; convert_mat(m, scr, gw, NGW, lane, base);
    { u32x4* z = (u32x4*)((bf16_t*)(ws + OFF_WIN) + (size_t)N1SRC * DM); const int n16 = (N1 - N1SRC) * DM * 2 / 16;
      for (int i = gw * 64 + lane; i < n16; i += NGW * 64) z[i] = (u32x4){0u, 0u, 0u, 0u}; }
}

__device__ __forceinline__ void prep_phase(const Params& P, int gw, int NGW, int lane) {
    unsigned char* ws = P.ws;
    float* cs = (float*)(ws + OFF_CS);
    for (int i = gw * 64 + lane; i < TT * 32; i += NGW * 64) {
        const int t = i >> 5, f = i & 31;
        const float inv = exp2f(-(float)f * (13.287712379549449f / 32.f));
        const float ang = (float)t * inv;
        const double a = (double)ang; const double k = rint(a * 0.15915494309189535); const float rr = (float)(a - k * 6.283185307179586);
        cs[i] = __cosf(rr); cs[TT * 32 + i] = __sinf(rr);
    }
    float* ss = (float*)(ws + OFF_SS);
    for (int i = gw * 64 + lane; i < 3 * MP; i += NGW * 64) ss[MP + i] = 0.f;
    bf16_t* XB = (bf16_t*)(ws + OFF_XB); float* xm = (float*)(ws + OFF_XM);
#define PREP_SRC(r_) ((r_) < MREAL ? P.x + (size_t)(r_) * DM : ((r_) < MVALID ? P.meta + (size_t)((r_) - MREAL) * DM : (const float*)nullptr))
#define PREP_LOAD(buf, r_) do { const float* src_ = PREP_SRC(r_); _Pragma("unroll") for (int j = 0; j < 8; ++j) \
        buf[j] = src_ ? __builtin_nontemporal_load((const f32x4*)(src_ + (j * 64 + lane) * 4)) : (f32x4){0.f, 0.f, 0.f, 0.f}; } while (0)
#define PREP_STORE(buf, r_) do { float s_ = 0.f; _Pragma("unroll") for (int j = 0; j < 8; ++j) { const f32x4 v = buf[j]; \
        s_ += (v[0] * v[0] + v[1] * v[1]) + (v[2] * v[2] + v[3] * v[3]); \
        u32x2 w; w.x = cvt_pk_bf16(v[0], v[1]); w.y = cvt_pk_bf16(v[2], v[3]); \
        *(u32x2*)(XB + (size_t)(r_) * DM + (j * 64 + lane) * 4) = w; \
        if ((r_) >= MREAL) *(f32x4*)(xm + (size_t)((r_) - MREAL) * DM + (j * 64 + lane) * 4) = v; } \
        s_ = wave_sum(s_); if (lane == 0) ss[(r_)] = s_; } while (0)
    f32x4 va[8], vb[8];
    int r = gw;
    if (r < MP) {
        PREP_LOAD(va, r);
        for (;;) {
            const int r1 = r + NGW; if (r1 < MP) PREP_LOAD(vb, r1);
            PREP_STORE(va, r);
            if (r1 >= MP) break;
            const int r2 = r1 + NGW; if (r2 < MP) PREP_LOAD(va, r2);
            PREP_STORE(vb, r1);
            if (r2 >= MP) break;
            r = r2;
        }
    }
#undef PREP_SRC
#undef PREP_LOAD
#undef PREP_STORE
}

__device__ __forceinline__ int prevrow(int r, int t, int j) { return (r < MREAL && (r & (SEQ - 1)) < j) ? MREAL + t - j : r - j; }
__device__ __forceinline__ void unpack8(const u32x4 w, float* e) { e[0] = bflo(w.x); e[1] = bfhi(w.x); e[2] = bflo(w.y); e[3] = bfhi(w.y); e[4] = bflo(w.z); e[5] = bfhi(w.z); e[6] = bflo(w.w); e[7] = bfhi(w.w); }
__device__ __forceinline__ u32x4 pack8f(const float* e) { u32x4 w; w.x = cvt_pk_bf16(e[0], e[1]); w.y = cvt_pk_bf16(e[2], e[3]); w.z = cvt_pk_bf16(e[4], e[5]); w.w = cvt_pk_bf16(e[6], e[7]); return w; }
__device__ __forceinline__ float ssq8(const u32x4 w) { float e[8]; unpack8(w, e); return (e[0] * e[0] + e[1] * e[1]) + (e[2] * e[2] + e[3] * e[3]) + (e[4] * e[4] + e[5] * e[5]) + (e[6] * e[6] + e[7] * e[7]); }
__device__ __forceinline__ void mix_phase(const Params& P, int l, int gw, int NGW, int lane, LAS unsigned char* lds) {
    unsigned char* ws = P.ws;
    bf16_t* P1 = (bf16_t*)(ws + OFF_P1); bf16_t* Q = (bf16_t*)(ws + OFF_Q); bf16_t* KF = (bf16_t*)(ws + OFF_KF); bf16_t* V = (bf16_t*)(ws + OFF_V); const bf16_t* Z = (const bf16_t*)(ws + OFF_Z);
    const float* cs = (const float*)(ws + OFF_CS);
    LAS float* Lq = (LAS float*)lds; LAS float* Lk = Lq + 192; LAS float* Lc = Lk + 192;
    for (int i = threadIdx.x; i < 192; i += 512) { Lq[i] = P.q_norm[l * DQK + i]; Lk[i] = P.k_norm[l * DQK + i]; }
    for (int i = threadIdx.x; i < 3072; i += 512) Lc[i] = P.conv_w[l * 3072 + i];
    __syncthreads();
    const int sub = lane & 3, h = lane >> 2;
    int eoff[6];
#pragma unroll
    for (int j = 0; j < 4; ++j) eoff[j] = sub * 8 + 32 * j;
    eoff[4] = 128 + sub * 8; eoff[5] = 160 + sub * 8;
    for (int r = gw; r < MVALID; r += NGW) {
        int t; if (r < MREAL) t = NMETA + (r & (SEQ - 1)); else t = r - MREAL;
        bf16_t* p1 = P1 + (size_t)r * N1;
        bf16_t* qp = Q + (size_t)r * 3072 + h * 192; bf16_t* kp = KF + (size_t)r * 3072 + h * 192; bf16_t* vp = V + (size_t)r * 2048 + h * 128;
        const u32x4 ql = *(const u32x4*)(p1 + C_QLAT + lane * 8), kl = *(const u32x4*)(p1 + C_KVLAT + lane * 8);
        u32x4 qv[6], kv[6], vv[4];
#pragma unroll
        for (int j = 0; j < 6; ++j) qv[j] = *(const u32x4*)(qp + eoff[j]);
#pragma unroll
        for (int j = 0; j < 4; ++j) kv[j] = *(const u32x4*)(kp + eoff[j]);
        kv[4] = *(const u32x4*)(p1 + C_KROPE + sub * 8); kv[5] = *(const u32x4*)(p1 + C_KROPE + 32 + sub * 8);
#pragma unroll
        for (int j = 0; j < 4; ++j) vv[j] = *(const u32x4*)(vp + eoff[j]);
        const f32x4 c0 = *(const f32x4*)(cs + t * 32 + sub * 8), c1 = *(const f32x4*)(cs + t * 32 + sub * 8 + 4);
        const f32x4 s0 = *(const f32x4*)(cs + TT * 32 + t * 32 + sub * 8), s1 = *(const f32x4*)(cs + TT * 32 + t * 32 + sub * 8 + 4);
        const float cc[8] = {c0[0], c0[1], c0[2], c0[3], c1[0], c1[1], c1[2], c1[3]}, sn[8] = {s0[0], s0[1], s0[2], s0[3], s1[0], s1[1], s1[2], s1[3]};
        const float aq = __builtin_amdgcn_rsqf(wave_sum(ssq8(ql)) * (1.f / 512.f) + EPS);
        const float akv = __builtin_amdgcn_rsqf(wave_sum(ssq8(kl)) * (1.f / 512.f) + EPS);
        {
            float e[6][8]; float ss = 0.f;
#pragma unroll
            for (int j = 0; j < 6; ++j) { unpack8(qv[j], e[j]);
#pragma unroll
                for (int i = 0; i < 8; ++i) { e[j][i] *= aq; ss += e[j][i] * e[j][i]; } }
            ss += __shfl_xor(ss, 1); ss += __shfl_xor(ss, 2);
            const float rn = __builtin_amdgcn_rsqf(ss * (1.f / 192.f) + EPS);
#pragma unroll
            for (int j = 0; j < 6; ++j) { const f32x4 g0 = *(const LAS f32x4*)(Lq + eoff[j]), g1 = *(const LAS f32x4*)(Lq + eoff[j] + 4);
#pragma unroll
                for (int i = 0; i < 4; ++i) { e[j][i] *= rn * g0[i]; e[j][4 + i] *= rn * g1[i]; } }
#pragma unroll
            for (int i = 0; i < 8; ++i) { const float x1 = e[4][i], x2 = e[5][i]; e[4][i] = x1 * cc[i] - x2 * sn[i]; e[5][i] = x2 * cc[i] + x1 * sn[i]; }
#pragma unroll
            for (int j = 0; j < 6; ++j) qv[j] = pack8f(e[j]);
        }
        {
            float e[6][8]; float ss = 0.f;
#pragma unroll
            for (int j = 0; j < 6; ++j) { unpack8(kv[j], e[j]);
#pragma unroll
                for (int i = 0; i < 8; ++i) { if (j < 4) e[j][i] *= akv; ss += e[j][i] * e[j][i]; } }
            ss += __shfl_xor(ss, 1); ss += __shfl_xor(ss, 2);
            const float rn = __builtin_amdgcn_rsqf(ss * (1.f / 192.f) + EPS);
#pragma unroll
            for (int j = 0; j < 6; ++j) { const f32x4 g0 = *(const LAS f32x4*)(Lk + eoff[j]), g1 = *(const LAS f32x4*)(Lk + eoff[j] + 4);
#pragma unroll
                for (int i = 0; i < 4; ++i) { e[j][i] *= rn * g0[i]; e[j][4 + i] *= rn * g1[i]; } }
#pragma unroll
            for (int i = 0; i < 8; ++i) { const float x1 = e[4][i], x2 = e[5][i]; e[4][i] = x1 * cc[i] - x2 * sn[i]; e[5][i] = x2 * cc[i] + x1 * sn[i]; }
#pragma unroll
            for (int j = 0; j < 6; ++j) kv[j] = pack8f(e[j]);
        }
#pragma unroll
        for (int j = 0; j < 4; ++j) { float e[8]; unpack8(vv[j], e);
#pragma unroll
            for (int i = 0; i < 8; ++i) e[i] *= akv;
            vv[j] = pack8f(e); }
        const int rm1 = t >= 1 ? prevrow(r, t, 1) : r, rm2 = t >= 2 ? prevrow(r, t, 2) : r;
        const float f1 = t >= 1 ? 1.f : 0.f, f2 = t >= 2 ? 1.f : 0.f;
        u32x4 cu[2][7];
#pragma unroll
        for (int hc = 0; hc < 2; ++hc) {
            const int ch = hc * 512 + lane * 8;
            const bf16_t* q1 = P1 + (size_t)rm1 * N1; const bf16_t* q2 = P1 + (size_t)rm2 * N1;
            cu[hc][0] = *(const u32x4*)(p1 + ch); cu[hc][1] = *(const u32x4*)(p1 + 2048 + ch);
            cu[hc][2] = *(const u32x4*)(q1 + ch); cu[hc][3] = *(const u32x4*)(q1 + 2048 + ch);
            cu[hc][4] = *(const u32x4*)(q2 + ch); cu[hc][5] = *(const u32x4*)(q2 + 2048 + ch);
            cu[hc][6] = *(const u32x4*)(p1 + 1024 + ch);
        }
#pragma unroll
        for (int j = 0; j < 6; ++j) *(u32x4*)(qp + eoff[j]) = qv[j];
#pragma unroll
        for (int j = 0; j < 6; ++j) *(u32x4*)(kp + eoff[j]) = kv[j];
#pragma unroll
        for (int j = 0; j < 4; ++j) *(u32x4*)(vp + eoff[j]) = vv[j];
        u32x4 co[2];
#pragma unroll
        for (int hc = 0; hc < 2; ++hc) {
            const int ch = hc * 512 + lane * 8;
            float a0[8], a1[8], a2[8], x[8], y[8], bb[8], o[8];
            unpack8(cu[hc][0], x); unpack8(cu[hc][1], y);
#pragma unroll
            for (int i = 0; i < 8; ++i) a0[i] = x[i] * y[i];
            unpack8(cu[hc][2], x); unpack8(cu[hc][3], y);
#pragma unroll
            for (int i = 0; i < 8; ++i) a1[i] = x[i] * y[i] * f1;
            unpack8(cu[hc][4], x); unpack8(cu[hc][5], y);
#pragma unroll
            for (int i = 0; i < 8; ++i) a2[i] = x[i] * y[i] * f2;
            unpack8(cu[hc][6], bb);
            const f32x4 w20 = *(const LAS f32x4*)(Lc + 2048 + ch), w21 = *(const LAS f32x4*)(Lc + 2048 + ch + 4), w10 = *(const LAS f32x4*)(Lc + 1024 + ch), w11 = *(const LAS f32x4*)(Lc + 1024 + ch + 4), w00 = *(const LAS f32x4*)(Lc + ch), w01 = *(const LAS f32x4*)(Lc + ch + 4);
            const float w2[8] = {w20[0], w20[1], w20[2], w20[3], w21[0], w21[1], w21[2], w21[3]}, w1[8] = {w10[0], w10[1], w10[2], w10[3], w11[0], w11[1], w11[2], w11[3]}, w0[8] = {w00[0], w00[1], w00[2], w00[3], w01[0], w01[1], w01[2], w01[3]};
#pragma unroll
            for (int i = 0; i < 8; ++i) o[i] = bb[i] * (w2[i] * a0[i] + w1[i] * a1[i] + w0[i] * a2[i]);
            co[hc] = pack8f(o);
        }
        u32x4 po[2];
#pragma unroll
        for (int hc = 0; hc < 2; ++hc) {
            const int ch = hc * 512 + lane * 8;
            const int wdw = 2 << (hc * 2 + (lane >> 5)); const int cnt = (t + 1) < wdw ? (t + 1) : wdw;
            const u32x4 z0 = *(const u32x4*)(Z + (size_t)r * 1024 + ch);
            float zc[8], acc[8]; unpack8(z0, zc);
#pragma unroll
            for (int i = 0; i < 8; ++i) acc[i] = zc[i];
            if (hc == 0) {
#pragma unroll
                for (int j = 1; j < 4; ++j) if (j < cnt) { float e[8]; unpack8(*(const u32x4*)(Z + (size_t)prevrow(r, t, j) * 1024 + ch), e);
#pragma unroll
                    for (int i = 0; i < 8; ++i) acc[i] += e[i]; }
            } else {
#pragma unroll
                for (int j = 1; j < 16; ++j) if (j < cnt) { float e[8]; unpack8(*(const u32x4*)(Z + (size_t)prevrow(r, t, j) * 1024 + ch), e);
#pragma unroll
                    for (int i = 0; i < 8; ++i) acc[i] += e[i]; }
            }
            const float ic = 1.f / (float)cnt; float o[8];
#pragma unroll
            for (int i = 0; i < 8; ++i) o[i] = acc[i] * ic - zc[i];
            po[hc] = pack8f(o);
        }
#pragma unroll
        for (int hc = 0; hc < 2; ++hc) { const int ch = hc * 512 + lane * 8; *(u32x4*)(p1 + 1024 + ch) = co[hc]; *(u32x4*)(p1 + C_POOL + ch) = po[hc]; }
    }
    __syncthreads();
}

#define XB_TMO      128
#define XB_XCNT(j)  (256  + 64 * (j))
#define XB_XSUB(j)  (1280 + 64 * (j))
#define XB_XGEN(j)  (2304 + 64 * (j))
#define XB_TOP      3328
#define XB_TOPGEN   3392
#define XCD_BAR_WORDS 3456
#define XB_SPIN_CAP (1u << 18)
__device__ __forceinline__ unsigned xb_ld(unsigned* p)              { return __hip_atomic_load(p, __ATOMIC_RELAXED, __HIP_MEMORY_SCOPE_AGENT); }
__device__ __forceinline__ unsigned xb_add(unsigned* p, unsigned v) { return __hip_atomic_fetch_add(p, v, __ATOMIC_RELAXED, __HIP_MEMORY_SCOPE_AGENT); }
__device__ __forceinline__ unsigned xb_xcc_id() { return (unsigned)__builtin_amdgcn_s_getreg((3 << 11) | 20) & 0xFu; }
#define XB_SPIN(cond, bar) do { unsigned _sp = 0; while (cond) { __builtin_amdgcn_s_sleep(1); \
    if ((++_sp & 255u) == 0u) { if (xb_ld(&(bar)[XB_TMO])) break; if (_sp > XB_SPIN_CAP) { atomicAdd(&(bar)[XB_TMO], 1u); break; } } } } while (0)
struct XcdBarrier { unsigned* bar; unsigned x; volatile LAS unsigned* st; };
__device__ __forceinline__ XcdBarrier xcd_barrier_post(unsigned* bar, volatile LAS unsigned* st) {
    XcdBarrier b; b.bar = bar; b.x = xb_xcc_id(); b.st = st;
    if (threadIdx.x == 0) (void)xb_add(&bar[XB_XCNT(b.x)], 1u);
    return b;
}
__device__ __forceinline__ void xcd_barrier_complete(unsigned* bar, unsigned x, unsigned& nloc, unsigned& nx) {
    const unsigned G = gridDim.x * gridDim.y * gridDim.z;
    unsigned sum, cnt, mine, sp = 0u;
    for (;;) {
        sum = 0u; cnt = 0u; mine = 0u;
#pragma unroll
        for (unsigned j = 0; j < 16; ++j) { const unsigned c = xb_ld(&bar[XB_XCNT(j)]); sum += c; cnt += (c > 0u) ? 1u : 0u; mine = (j == x) ? c : mine; }
        if (sum == G) break;
        __builtin_amdgcn_s_sleep(1);
        if ((++sp & 255u) == 0u) { if (xb_ld(&bar[XB_TMO])) break; if (sp > XB_SPIN_CAP) { atomicAdd(&bar[XB_TMO], 1u); break; } }
    }
    nloc = mine > 0u ? mine : 1u; nx = cnt > 0u ? cnt : 1u;
}
__device__ __forceinline__ void xcd_barrier(const XcdBarrier& b) {
    asm volatile("s_waitcnt vmcnt(0)" ::: "memory");
    __syncthreads();
    if (threadIdx.x == 0) {
        unsigned* bar = b.bar;
        __builtin_amdgcn_s_waitcnt(0);
        unsigned nloc = b.st[0], nx = b.st[1];
        if (nloc == 0u) { xcd_barrier_complete(bar, b.x, nloc, nx); b.st[0] = nloc; b.st[1] = nx; }
        const unsigned old = xb_add(&bar[XB_XSUB(b.x)], 1u);
        const unsigned gen = old / nloc;
        if (old + 1u == (gen + 1u) * nloc) {
            __builtin_amdgcn_fence(__ATOMIC_RELEASE, "agent");
            asm volatile("s_waitcnt vmcnt(0)" ::: "memory");
            const unsigned og = xb_add(&bar[XB_TOP], 1u);
            const unsigned tg = og / nx;
            if (og + 1u == (tg + 1u) * nx) xb_add(&bar[XB_TOPGEN], 1u);
            else XB_SPIN(xb_ld(&bar[XB_TOPGEN]) == tg, bar);
            __builtin_amdgcn_fence(__ATOMIC_ACQUIRE, "agent");
            xb_add(&bar[XB_XGEN(b.x)], 1u);
            asm volatile("s_waitcnt vmcnt(0)" ::: "memory");
        } else {
            XB_SPIN(xb_ld(&bar[XB_XGEN(b.x)]) == gen, bar);
            __builtin_amdgcn_fence(__ATOMIC_ACQUIRE, "agent");
            asm volatile("s_waitcnt vmcnt(0)" ::: "memory");
        }
    }
    __syncthreads();
}

__device__ __forceinline__ void fill_desc(pg8::GDesc& d, const Params& P, unsigned char* ws, int l, int gid) {
    bf16_t* P1 = (bf16_t*)(ws + OFF_P1); float* ss = (float*)(ws + OFF_SS);
    d.ws = ws; d.amode = 0; d.epi = 0; d.O = nullptr; d.ldc = 0; d.ss = nullptr; d.ssacc = nullptr; d.Gt = nullptr; d.src = nullptr; d.dst = nullptr; d.act = 0; d.first = 0; d.lastout = 0;
    switch (gid) {
    case 0: d.A = (const char*)(ws + OFF_XB); d.lda = DM; d.Bt = (const char*)(ws + OFF_WIN); d.ldb = DM; d.nt = DM / 64; d.nN = N1 / 256; d.O = P1; d.ldc = N1; d.ss = ss + (2 * l) * MP; break;
    case 1: d.A = (const char*)(P1 + C_QLAT); d.lda = N1; d.Bt = (const char*)(ws + OFF_WUQ); d.ldb = 512; d.nt = 8; d.nN = 12; d.O = (bf16_t*)(ws + OFF_Q); d.ldc = 3072; break;
    case 2: d.A = (const char*)(P1 + C_KVLAT); d.lda = N1; d.Bt = (const char*)(ws + OFF_WUKV); d.ldb = 512; d.nt = 8; d.nN = 16; d.epi = 1; break;
    case 3: d.A = (const char*)(P1 + C_POOL); d.lda = N1; d.Bt = (const char*)(ws + OFF_WPOOL); d.ldb = 256; d.nt = 4; d.nN = 4; d.amode = 1; d.O = (bf16_t*)(ws + OFF_Z); d.ldc = 1024; break;
    case 4: d.A = (const char*)(ws + OFF_XB); d.lda = DM; d.Bt = (const char*)(ws + OFF_WIN + (size_t)N1 * DM * 2); d.ldb = DM; d.nt = DM / 64; d.nN = NG / 256; d.O = (bf16_t*)(ws + OFF_G); d.ldc = NG; d.ss = ss + (2 * l) * MP; d.act = 1; break;
    case 5: d.A = (const char*)(P1 + 1024); d.lda = N1; d.Bt = (const char*)(ws + OFF_WA); d.ldb = 1024; d.nt = 16; d.nN = 8; d.epi = 2; d.O = P1 + 2048; d.ldc = N1; d.Gt = (const bf16_t*)(ws + OFF_G); d.first = 1; break;
    case 6: d.A = (const char*)(ws + OFF_Q); d.lda = 3072; d.Bt = (const char*)(ws + OFF_WB); d.ldb = 2048; d.nt = 32; d.nN = 8; d.amode = 2; d.epi = 2; d.O = P1 + 2048; d.ldc = N1; d.Gt = (const bf16_t*)(ws + OFF_G) + 2048; break;
    case 7: d.A = (const char*)(P1 + C_POOL); d.lda = N1; d.Bt = (const char*)(ws + OFF_WC); d.ldb = 1024; d.nt = 16; d.nN = 8; d.epi = 2; d.O = P1 + 2048; d.ldc = N1; d.Gt = (const bf16_t*)(ws + OFF_G) + 4096; break;
    case 8: d.A = (const char*)(P1 + 2048); d.lda = N1; d.Bt = (const char*)(ws + OFF_WO); d.ldb = 2048; d.nt = 32; d.nN = 8; d.epi = 3; d.src = l == 0 ? P.x : P.out; d.dst = P.out; d.ssacc = ss + (2 * l + 1) * MP; break;
    case 9: d.A = (const char*)(ws + OFF_XB); d.lda = DM; d.Bt = (const char*)(ws + OFF_WUP); d.ldb = DM; d.nt = DM / 64; d.nN = DFF / 256; d.O = (bf16_t*)(ws + OFF_H); d.ldc = DFF; d.ss = ss + (2 * l + 1) * MP; d.act = 2; break;
    default: d.A = (const char*)(ws + OFF_H); d.lda = DFF; d.Bt = (const char*)(ws + OFF_WDN); d.ldb = DFF; d.nt = DFF / 64; d.nN = 8; d.epi = 3; d.src = P.out; d.dst = P.out; d.ssacc = l == 0 ? ss + 2 * MP : nullptr; d.lastout = l; break;
    }
}

__global__ void __launch_bounds__(512, 2) fwd_megakernel(Params P) {
    extern __shared__ __attribute__((aligned(16))) unsigned char lds[];
    cg::grid_group grid = cg::this_grid();
    volatile LAS unsigned* bst = (volatile LAS unsigned*)((LAS unsigned char*)lds + LDS_BAR_OFF);
    if (threadIdx.x < 16) bst[threadIdx.x] = 0u;
    __syncthreads();
    const XcdBarrier bar = xcd_barrier_post((unsigned*)(P.ws + OFF_BAR), bst);
    {
        const int tid = opaque_tid(), lane = tid & 63, wave = __builtin_amdgcn_readfirstlane(tid >> 6);
        const int G = gridDim.x, bx = blockIdx.x, vcu = (G % 8 == 0) ? (bx % 8) * (G / 8) + bx / 8 : bx;
        prep_phase(P, vcu * 8 + wave, G * 8, lane);
    }
#ifndef DBL_MASK
#define DBL_MASK 0
#endif
    int rep = 0;
#pragma unroll 1
    for (int step = 0; step < 28; ++step) {
        const int l = step >= 14 ? 1 : 0, s = step - 14 * l;
        if (((DBL_MASK >> s) & 1) && rep == 0) { rep = 1; --step; } else rep = 0;
        unsigned char* ws = P.ws; asm volatile("" : "+s"(ws));
        const int G = gridDim.x, bx = blockIdx.x;
        bool sync = true;
        if (s == 0 || s == 5 || s == 6) {
            const int tid = opaque_tid(), lane = tid & 63, wave = __builtin_amdgcn_readfirstlane(tid >> 6);
            const int vcu = (G % 8 == 0) ? (bx % 8) * (G / 8) + bx / 8 : bx;
            if (s == 0) {
#ifndef NO_CONV
                convert_weights(P, l, (LAS unsigned char*)lds, vcu * 8 + wave, G * 8, wave, lane);
#endif
            } else if (s == 5) {
#ifndef NO_MIX
                mix_phase(P, l, vcu * 8 + wave, G * 8, lane, (LAS unsigned char*)lds);
#endif
            } else {
#ifndef NO_ATTN
                att::Tens T{ws}; att::attn_phase((char*)lds, T, vcu, G, ((DBL_MASK >> 6) & 1) && rep == 1, l == 0);
#endif
            }
        } else {
            const int gid = s < 5 ? s - 1 : s - 3;
            sync = !(gid == 1 || gid == 2 || gid == 5 || gid == 6);
            pg8::GDesc d; fill_desc(d, P, ws, l, gid);
#ifndef NO_GEMM
            if (!(l == 1 && gid >= 4)) pg8::skinny_gemm((LAS unsigned char*)lds, d, G, bx);
            pg8::gemm_generic((LAS unsigned char*)lds, d, G, bx);
#endif
        }
        if (sync && step != 27) { if (step == 0) grid.sync(); else xcd_barrier(bar); }
    }
}

extern "C" void kernel_launch(void* const* d_in, const int* in_sizes, int n_in, void* d_out, int out_size, void* d_ws, size_t ws_size, hipStream_t stream) {
    static int grid_blocks = 0;
    if (grid_blocks == 0) {
        if (n_in != 20 || ws_size < WS_NEED || out_size != MREAL * DM) { fprintf(stderr, "kernel_launch: unexpected shapes (n_in %d, ws %zu need %zu, out %d)\n", n_in, ws_size, (size_t)WS_NEED, out_size); grid_blocks = -1; return; }
        int dev = 0, cus = 0, per_cu = 0;
        hipGetDevice(&dev);
        hipDeviceGetAttribute(&cus, hipDeviceAttributeMultiprocessorCount, dev);
        hipFuncSetAttribute((const void*)fwd_megakernel, hipFuncAttributeMaxDynamicSharedMemorySize, LDS_BYTES);
        hipOccupancyMaxActiveBlocksPerMultiprocessor(&per_cu, (const void*)fwd_megakernel, 512, LDS_BYTES);
        if (per_cu < 1) { fprintf(stderr, "kernel_launch: occupancy query says %d blocks per CU\n", per_cu); per_cu = 1; }
        (void)hipGetLastError();
        grid_blocks = cus;
    }
    if (grid_blocks < 0) return;
    Params p{};
    p.x = (const float*)d_in[0]; p.meta = (const float*)d_in[1]; p.attn_norm = (const float*)d_in[2]; p.w_in = (const float*)d_in[3]; p.conv_w = (const float*)d_in[4];
    p.q_lat_norm = (const float*)d_in[5]; p.kv_lat_norm = (const float*)d_in[6]; p.w_uq = (const float*)d_in[7]; p.w_ukv = (const float*)d_in[8]; p.q_norm = (const float*)d_in[9];
    p.k_norm = (const float*)d_in[10]; p.pool_w = (const float*)d_in[11]; p.pool_scale = (const float*)d_in[12]; p.w_a = (const float*)d_in[13]; p.w_b = (const float*)d_in[14];
    p.w_c = (const float*)d_in[15]; p.w_o = (const float*)d_in[16]; p.mlp_norm = (const float*)d_in[17]; p.w_up = (const float*)d_in[18]; p.w_down = (const float*)d_in[19];
    p.out = (float*)d_out; p.ws = (unsigned char*)d_ws;
    if (hipMemsetAsync((char*)d_ws + OFF_BAR, 0, BAR_BYTES, stream) != hipSuccess) { fprintf(stderr, "kernel_launch: memset of barrier words failed\n"); return; }
    void* args[] = {&p};
    hipError_t e = hipLaunchCooperativeKernel((const void*)fwd_megakernel, dim3(grid_blocks), dim3(512), args, LDS_BYTES, stream);
    if (e != hipSuccess) fprintf(stderr, "cooperative launch failed: %s (grid %d)\n", hipGetErrorString(e), grid_blocks);
}
```

```cpp
#include <hip/hip_runtime.h>
#include <hip/hip_cooperative_groups.h>
#include <cstdio>
#include <cstdint>
namespace cg = cooperative_groups;

#define LAS __attribute__((address_space(3)))
typedef unsigned short bf16_t;
typedef short bf16x8 __attribute__((ext_vector_type(8)));
typedef short s16x4 __attribute__((ext_vector_type(4)));
typedef float f32x4 __attribute__((ext_vector_type(4)));
typedef float f32x16 __attribute__((ext_vector_type(16)));
typedef unsigned u32x4 __attribute__((ext_vector_type(4)));
typedef unsigned u32x2 __attribute__((ext_vector_type(2)));

constexpr int DM = 2048, NBATCH = 4, SEQ = 4096, NMETA = 16, TT = SEQ + NMETA;
constexpr int MREAL = NBATCH * SEQ;
constexpr int MVALID = MREAL + NMETA;
constexpr int MP = 16640;
constexpr int NH = 16, DQK = 192, DV = 128;
constexpr int N1 = 5376;
constexpr int C_QLAT = 3072, C_KVLAT = 3584, C_KROPE = 4096, C_POOL = 4160, N1SRC = 5184;
constexpr int NG = 6144, DIN = 11328, DFF = 8192;
constexpr float EPS = 1e-6f;

constexpr size_t SZ_WIN = (size_t)(N1 + NG) * DM * 2, SZ_WUQ = (size_t)3072 * 512 * 2, SZ_WUKV = (size_t)4096 * 512 * 2, SZ_WPOOL = (size_t)1024 * 256 * 2;
constexpr size_t SZ_WA = (size_t)2048 * 1024 * 2, SZ_WB = (size_t)2048 * 2048 * 2, SZ_WUP = (size_t)DFF * DM * 2;
constexpr size_t OFF_WIN = 0, OFF_WUQ = OFF_WIN + SZ_WIN, OFF_WUKV = OFF_WUQ + SZ_WUQ, OFF_WPOOL = OFF_WUKV + SZ_WUKV, OFF_WA = OFF_WPOOL + SZ_WPOOL,
                 OFF_WB = OFF_WA + SZ_WA, OFF_WC = OFF_WB + SZ_WB, OFF_WO = OFF_WC + SZ_WA, OFF_WUP = OFF_WO + SZ_WB, OFF_WDN = OFF_WUP + SZ_WUP, OFF_WEND = OFF_WDN + SZ_WUP;
constexpr size_t OFF_XB = OFF_WEND;
constexpr size_t OFF_P1 = OFF_XB + (size_t)MP * DM * 2;
constexpr size_t OFF_Q = OFF_P1 + (size_t)MP * N1 * 2;
constexpr size_t OFF_KF = OFF_Q + (size_t)MP * 3072 * 2;
constexpr size_t OFF_V = OFF_KF + (size_t)MP * 3072 * 2;
constexpr size_t OFF_Z = OFF_V + (size_t)MP * 2048 * 2;
constexpr size_t OFF_G = OFF_KF;
constexpr size_t OFF_H = OFF_Q;
constexpr size_t OFF_XM = OFF_Z + (size_t)MP * 1024 * 2;
constexpr size_t OFF_SS = OFF_XM + (size_t)256 * DM * 4;
constexpr size_t OFF_CS = OFF_SS + (size_t)4 * MP * 4;
constexpr size_t OFF_BAR = OFF_CS + (size_t)2 * TT * 32 * 4;
constexpr size_t BAR_BYTES = 16384;
constexpr size_t WS_NEED = OFF_BAR + BAR_BYTES;
static_assert(OFF_G + (size_t)MP * NG * 2 <= OFF_XM && OFF_H + (size_t)MP * DFF * 2 <= OFF_XM, "overlays");

constexpr int LDS_BAR_OFF = 155648, LDS_BYTES = 155648 + 64;
#ifndef SKIP
#define SKIP 0
#endif

__device__ __forceinline__ unsigned cvt_pk_bf16(float lo, float hi) { unsigned r; asm volatile("v_cvt_pk_bf16_f32 %0, %1, %2" : "=v"(r) : "v"(lo), "v"(hi)); return r; }
__device__ __forceinline__ float bf2f(unsigned v) { return __uint_as_float(v << 16); }
__device__ __forceinline__ float bflo(unsigned w) { return __uint_as_float(w << 16); }
__device__ __forceinline__ float bfhi(unsigned w) { return __uint_as_float(w & 0xffff0000u); }
__device__ __forceinline__ bf16_t f2bf(float f) { return (bf16_t)(cvt_pk_bf16(f, 0.f) & 0xffffu); }
__device__ __forceinline__ float wave_sum(float v) {
#pragma unroll
    for (int o = 1; o < 64; o <<= 1) v += __shfl_xor(v, o);
    return v;
}
__device__ __forceinline__ int opaque_tid() { int t = threadIdx.x; asm volatile("" : "+v"(t)); return t; }
__device__ __forceinline__ int tokrow(int b, int p) { return p < NMETA ? MREAL + p : b * SEQ - NMETA + (p < TT ? p : TT - 1); }

namespace pg8 {
constexpr int BM = 256, BK = 64, HALF = 128, HTB = HALF * BK * 2, STAGE_BYTES = 8 * HTB, NXCD = 8, WGM = 8;
__device__ __forceinline__ int lds_byte(int r, int c) { const int st = (r >> 4) * 2 + (c >> 5), rr = r & 15, cc = c & 31, ob = rr * 64 + cc * 2; return st * 1024 + (ob ^ (((ob >> 9) & 1) << 5)); }
__device__ __forceinline__ void stage_rc(int b, int& R, int& C) { const int st = b / 1024, sb = b % 1024, swz = sb ^ (((sb >> 9) & 1) << 5); R = (st >> 1) * 16 + swz / 64; C = (st & 1) * 32 + (swz % 64) / 2; }
__device__ __forceinline__ int perm32(int rho) { const int n = rho >> 4, i = rho & 15; return 8 * (i >> 2) + 4 * n + (i & 3); }

struct Unit { int pm, pn; };

struct StaticOrder {
    int nM, nN, nwg, G, c;
    __device__ void init(int nM_, int nN_, int G_, int c_) { nM = nM_; nN = nN_; nwg = nM * nN; G = G_; c = c_; }
    __device__ bool next(int i, Unit& u) const {
        const long L = (long)i * G + c; if (L >= nwg) return false;
        int wgid = (int)L; { const int q = nwg / NXCD, r = nwg % NXCD, xcd = wgid % NXCD, off = wgid / NXCD; wgid = (xcd < r ? xcd * (q + 1) : r * (q + 1) + (xcd - r) * q) + off; }
        const int nig = WGM * nN, gid = wgid / nig, fm = gid * WGM, gsz = (nM - fm) < WGM ? (nM - fm) : WGM;
        u.pm = fm + ((wgid % nig) % gsz); u.pn = (wgid % nig) / gsz; return true;
    }
};
struct GDesc {
    const char* A; const char* Bt; int lda, ldb, nt, nN, amode, epi;
    bf16_t* O; int ldc; const float* ss; float* ssacc; const bf16_t* Gt; const float* src; float* dst; int act, first; unsigned char* ws; int lastout;
};
__device__ __forceinline__ size_t a_base(const GDesc& d, const Unit& u, size_t tstepA) { return (size_t)u.pm * tstepA + (d.amode == 1 ? (size_t)u.pn * 512 : (size_t)0); }
__device__ __forceinline__ size_t a_koff(const GDesc& d, int kt) { return d.amode == 2 ? (size_t)(kt >> 1) * 384 + (size_t)(kt & 1) * 128 : (size_t)kt * 128; }

__device__ __forceinline__ void run_epi(const GDesc& d, const f32x4 (&acc)[2][2][4][2], const Unit& u, int wr, int wc, int fr, int fq) {
    const int epi = d.epi;
    const int row0 = u.pm * BM + wr * 64 + fr, col0 = u.pn * BM + wc * 32 + 8 * fq;
    if (epi == 0) {
        float rsv[2][4];
#pragma unroll
        for (int ai = 0; ai < 2; ++ai)
#pragma unroll
            for (int m = 0; m < 4; ++m) rsv[ai][m] = d.ss ? d.ss[row0 + ai * HALF + m * 16] : 0.f;
#pragma unroll
        for (int ai = 0; ai < 2; ++ai)
#pragma unroll
            for (int m = 0; m < 4; ++m) {
                const int row = row0 + ai * HALF + m * 16;
                const float rs = d.ss ? __builtin_amdgcn_rsqf(rsv[ai][m] * (1.0f / DM) + EPS) : 1.f;
#pragma unroll
                for (int bj = 0; bj < 2; ++bj) {
                    const f32x4 v0 = acc[ai][bj][m][0], v1 = acc[ai][bj][m][1];
                    float v[8] = {v0[0], v0[1], v0[2], v0[3], v1[0], v1[1], v1[2], v1[3]};
#pragma unroll
                    for (int i = 0; i < 8; ++i) { float x = v[i] * rs;
                        if (d.act == 1) x = __builtin_amdgcn_rcpf(1.f + __builtin_amdgcn_exp2f(-1.4426950408889634f * x));
                        else if (d.act == 2) { x = fmaxf(x, 0.f); x = x * x; }
                        v[i] = x; }
                    u32x4 w; w.x = cvt_pk_bf16(v[0], v[1]); w.y = cvt_pk_bf16(v[2], v[3]); w.z = cvt_pk_bf16(v[4], v[5]); w.w = cvt_pk_bf16(v[6], v[7]);
                    *(u32x4*)(d.O + (size_t)row * d.ldc + col0 + bj * HALF) = w;
                }
            }
    } else if (epi == 1) {
#pragma unroll
        for (int ai = 0; ai < 2; ++ai)
#pragma unroll
            for (int m = 0; m < 4; ++m) {
                const int row = row0 + ai * HALF + m * 16;
#pragma unroll
                for (int bj = 0; bj < 2; ++bj) {
                    const f32x4 v0 = acc[ai][bj][m][0], v1 = acc[ai][bj][m][1];
                    u32x4 w; w.x = cvt_pk_bf16(v0[0], v0[1]); w.y = cvt_pk_bf16(v0[2], v0[3]); w.z = cvt_pk_bf16(v1[0], v1[1]); w.w = cvt_pk_bf16(v1[2], v1[3]);
                    const int c = wc * 32 + 8 * fq;
                    bf16_t* p = bj == 0 ? (bf16_t*)(d.ws + OFF_KF) + (size_t)row * 3072 + u.pn * 192 + c : (bf16_t*)(d.ws + OFF_V) + (size_t)row * 2048 + u.pn * 128 + c;
                    *(u32x4*)p = w;
                }
            }
    } else if (epi == 2) {
#pragma unroll
        for (int ai = 0; ai < 2; ++ai) {
            u32x4 g[4][2], o[4][2];
#pragma unroll
            for (int m = 0; m < 4; ++m)
#pragma unroll
                for (int bj = 0; bj < 2; ++bj) {
                    const int row = row0 + ai * HALF + m * 16, col = col0 + bj * HALF;
                    g[m][bj] = *(const u32x4*)(d.Gt + (size_t)row * NG + col);
                    o[m][bj] = d.first ? (u32x4){0u, 0u, 0u, 0u} : *(const u32x4*)(d.O + (size_t)row * d.ldc + col);
                }
#pragma unroll
            for (int m = 0; m < 4; ++m)
#pragma unroll
                for (int bj = 0; bj < 2; ++bj) {
                    const int row = row0 + ai * HALF + m * 16, col = col0 + bj * HALF;
                    const f32x4 v0 = acc[ai][bj][m][0], v1 = acc[ai][bj][m][1]; const u32x4 gg = g[m][bj], oo = o[m][bj];
                    u32x4 w;
                    w.x = cvt_pk_bf16(v0[0] * bflo(gg.x) + bflo(oo.x), v0[1] * bfhi(gg.x) + bfhi(oo.x)); w.y = cvt_pk_bf16(v0[2] * bflo(gg.y) + bflo(oo.y), v0[3] * bfhi(gg.y) + bfhi(oo.y));
                    w.z = cvt_pk_bf16(v1[0] * bflo(gg.z) + bflo(oo.z), v1[1] * bfhi(gg.z) + bfhi(oo.z)); w.w = cvt_pk_bf16(v1[2] * bflo(gg.w) + bflo(oo.w), v1[3] * bfhi(gg.w) + bfhi(oo.w));
                    *(u32x4*)(d.O + (size_t)row * d.ldc + col) = w;
                }
        }
    } else {
        bf16_t* XBp = (bf16_t*)(d.ws + OFF_XB);
#pragma unroll
        for (int ai = 0; ai < 2; ++ai) {
            u32x4 xo[4][2];
#pragma unroll
            for (int m = 0; m < 4; ++m)
#pragma unroll
                for (int bj = 0; bj < 2; ++bj) xo[m][bj] = *(const u32x4*)(XBp + (size_t)(row0 + ai * HALF + m * 16) * DM + col0 + bj * HALF);
#pragma unroll
            for (int m = 0; m < 4; ++m) {
                const int row = row0 + ai * HALF + m * 16; float sq = 0.f;
#pragma unroll
                for (int bj = 0; bj < 2; ++bj) {
                    const int col = col0 + bj * HALF; const u32x4 xx = xo[m][bj];
                    const f32x4 v0 = acc[ai][bj][m][0], v1 = acc[ai][bj][m][1];
                    const f32x4 a0 = (f32x4){bflo(xx.x) + v0[0], bfhi(xx.x) + v0[1], bflo(xx.y) + v0[2], bfhi(xx.y) + v0[3]};
                    const f32x4 a1 = (f32x4){bflo(xx.z) + v1[0], bfhi(xx.z) + v1[1], bflo(xx.w) + v1[2], bfhi(xx.w) + v1[3]};
                    if (d.lastout) { float* dp = d.dst + (size_t)row * DM + col; *(f32x4*)dp = a0; *(f32x4*)(dp + 4) = a1; }
                    else { u32x4 w; w.x = cvt_pk_bf16(a0[0], a0[1]); w.y = cvt_pk_bf16(a0[2], a0[3]); w.z = cvt_pk_bf16(a1[0], a1[1]); w.w = cvt_pk_bf16(a1[2], a1[3]);
                        *(u32x4*)(XBp + (size_t)row * DM + col) = w; }
                    sq += (a0[0] * a0[0] + a0[1] * a0[1]) + (a0[2] * a0[2] + a0[3] * a0[3]) + (a1[0] * a1[0] + a1[1] * a1[1]) + (a1[2] * a1[2] + a1[3] * a1[3]);
                }
                if (d.ssacc) { sq += __shfl_xor(sq, 16); sq += __shfl_xor(sq, 32); if (fq == 0) atomicAdd(d.ssacc + row, sq); }
            }
        }
    }
}

__device__ __forceinline__ void skinny_gemm(LAS unsigned char* lds, const GDesc& d, int G, int bx) {
    const int tid = opaque_tid(), wid = __builtin_amdgcn_readfirstlane(tid >> 6), lane = tid & 63, fr = lane & 15, fq = lane >> 4;
    const int ntask = d.nN * 16, steps = d.nt >> 2;
    LAS f32x4* red = (LAS f32x4*)lds;
    for (int t = bx; t < ntask; t += G) {
        const int n0 = t * 16;
        const char* arow = d.A + (size_t)(MREAL + fr) * d.lda * 2 + (d.amode == 1 ? (size_t)(n0 >> 8) * 512 : (size_t)0);
        const char* brow = d.Bt + (size_t)(n0 + fr) * d.ldb * 2;
        f32x4 acc = (f32x4){0.f, 0.f, 0.f, 0.f};
        const int kbeg = wid * steps * 32 + fq * 8;
#pragma unroll 8
        for (int st = 0; st < steps; ++st) {
            const int k = kbeg + st * 32;
            const int ka = d.amode == 2 ? (k >> 7) * 192 + (k & 127) : k;
            const bf16x8 a = *(const bf16x8*)(arow + (size_t)ka * 2); const bf16x8 b = *(const bf16x8*)(brow + (size_t)k * 2);
            acc = __builtin_amdgcn_mfma_f32_16x16x32_bf16(b, a, acc, 0, 0, 0);
        }
        red[wid * 64 + lane] = acc;
        __syncthreads();
        if (wid == 0) {
            f32x4 v = red[lane];
#pragma unroll
            for (int w_ = 1; w_ < 8; ++w_) v += red[w_ * 64 + lane];
            const int row = MREAL + fr, col = n0 + 4 * fq, epi = d.epi;
            if (epi == 0) {
                const float rs = d.ss ? __builtin_amdgcn_rsqf(d.ss[row] * (1.0f / DM) + EPS) : 1.f;
#pragma unroll
                for (int i = 0; i < 4; ++i) { float x = v[i] * rs;
                    if (d.act == 1) x = __builtin_amdgcn_rcpf(1.f + __builtin_amdgcn_exp2f(-1.4426950408889634f * x));
                    else if (d.act == 2) { x = fmaxf(x, 0.f); x = x * x; }
                    v[i] = x; }
                u32x2 w; w.x = cvt_pk_bf16(v[0], v[1]); w.y = cvt_pk_bf16(v[2], v[3]);
                *(u32x2*)(d.O + (size_t)row * d.ldc + col) = w;
            } else if (epi == 1) {
                const int h = col >> 8, c = col & 255;
                bf16_t* p = c < 128 ? (bf16_t*)(d.ws + OFF_KF) + (size_t)row * 3072 + h * 192 + c : (bf16_t*)(d.ws + OFF_V) + (size_t)row * 2048 + h * 128 + (c - 128);
                u32x2 w; w.x = cvt_pk_bf16(v[0], v[1]); w.y = cvt_pk_bf16(v[2], v[3]);
                *(u32x2*)p = w;
            } else if (epi == 2) {
                const u32x2 g = *(const u32x2*)(d.Gt + (size_t)row * NG + col);
                v[0] *= bflo(g.x); v[1] *= bfhi(g.x); v[2] *= bflo(g.y); v[3] *= bfhi(g.y);
                bf16_t* p = d.O + (size_t)row * d.ldc + col;
                if (!d.first) { const u32x2 o = *(const u32x2*)p; v[0] += bflo(o.x); v[1] += bfhi(o.x); v[2] += bflo(o.y); v[3] += bfhi(o.y); }
                u32x2 w; w.x = cvt_pk_bf16(v[0], v[1]); w.y = cvt_pk_bf16(v[2], v[3]);
                *(u32x2*)p = w;
            } else {
                float* xp = (float*)(d.ws + OFF_XM) + (size_t)fr * DM + col;
                const f32x4 a0 = *(const f32x4*)xp + v;
                *(f32x4*)xp = a0;
                u32x2 w; w.x = cvt_pk_bf16(a0[0], a0[1]); w.y = cvt_pk_bf16(a0[2], a0[3]);
                *(u32x2*)((bf16_t*)(d.ws + OFF_XB) + (size_t)row * DM + col) = w;
                float sq = (a0[0] * a0[0] + a0[1] * a0[1]) + (a0[2] * a0[2] + a0[3] * a0[3]);
                sq += __shfl_xor(sq, 16); sq += __shfl_xor(sq, 32);
                if (fq == 0 && d.ssacc) atomicAdd(d.ssacc + row, sq);
            }
        }
        __syncthreads();
    }
}

__device__ __forceinline__ void gemm_generic(LAS unsigned char* lds, const GDesc& d, int G, int bx) {
    StaticOrder S; S.init(MREAL / 256, d.nN, G, bx);
    const int tid = opaque_tid(), wid = __builtin_amdgcn_readfirstlane(tid >> 6), lane = tid & 63, wr = wid >> 2, wc = wid & 3, fr = lane & 15, fq = lane >> 4;
    const int nt = d.nt;
    unsigned voffA[2], voffB[2];
#pragma unroll
    for (int i = 0; i < 2; ++i) { int R, C; stage_rc(tid * 16 + i * 8192, R, C); const int Rb = (R & ~31) + perm32(R & 31);
        voffA[i] = (unsigned)(R * d.lda + C) * 2u; voffB[i] = (unsigned)(Rb * d.ldb + C) * 2u; }
    const size_t kstep = (size_t)(BK * 2);
    const size_t hstepA = (size_t)HALF * d.lda * 2, hstepB = (size_t)HALF * d.ldb * 2, tstepB = 2 * hstepB, tstepA = 2 * hstepA;
    const unsigned ldsw = (unsigned)wid * 1024u;
    const int aoff = lds_byte(wr * 64 + fr, fq * 8), boff = lds_byte(wc * 32 + fr, fq * 8);
#define PG8_SA(b, h) (((b) * 2 + (h)) * HTB)
#define PG8_SB(b, h) ((4 + (b) * 2 + (h)) * HTB)
#define PG8_STAGE(bufoff, gbase, voff) do { _Pragma("unroll") for (int _i = 0; _i < 2; ++_i) \
        __builtin_amdgcn_global_load_lds((const unsigned*)((const char*)(gbase) + (voff)[_i]), (LAS unsigned*)(lds + (bufoff) + ldsw + _i * 8192), 16, 0, 0); } while (0)
#define PG8_LDA(dst, b, h) do { _Pragma("unroll") for (int m = 0; m < 4; ++m) _Pragma("unroll") for (int k = 0; k < 2; ++k) dst[m][k] = *(const LAS bf16x8*)(lds + PG8_SA(b, h) + aoff + m * 2048 + k * 1024); } while (0)
#define PG8_LDB(dst, b, h) do { _Pragma("unroll") for (int n = 0; n < 2; ++n) _Pragma("unroll") for (int k = 0; k < 2; ++k) dst[n][k] = *(const LAS bf16x8*)(lds + PG8_SB(b, h) + boff + n * 2048 + k * 1024); } while (0)
#define PG8_MMA(ai, bj, At, Bt) do { __builtin_amdgcn_s_setprio(1); _Pragma("unroll") for (int m = 0; m < 4; ++m) _Pragma("unroll") for (int n = 0; n < 2; ++n) _Pragma("unroll") for (int k = 0; k < 2; ++k) \
        acc[ai][bj][m][n] = __builtin_amdgcn_mfma_f32_16x16x32_bf16(Bt[n][k], At[m][k], acc[ai][bj][m][n], 0, 0, 0); __builtin_amdgcn_s_setprio(0); } while (0)
#define PG8_WAIT_V(n) asm volatile("s_waitcnt vmcnt(" #n ")" ::: "memory")
#define PG8_WAIT_L(n) asm volatile("s_waitcnt lgkmcnt(" #n ")" ::: "memory")
#define PG8_BAR __builtin_amdgcn_s_barrier()
#define PG8_SCHED __builtin_amdgcn_sched_barrier(0)
    Unit cur, nxt; int ui = 0;
    if (!S.next(0, cur)) return;
    f32x4 acc[2][2][4][2];
#pragma unroll
    for (int a = 0; a < 2; ++a)
#pragma unroll
        for (int b = 0; b < 2; ++b)
#pragma unroll
            for (int m = 0; m < 4; ++m)
#pragma unroll
                for (int n = 0; n < 2; ++n) acc[a][b][m][n] = (f32x4){0.f, 0.f, 0.f, 0.f};
    bf16x8 At[4][2], B0[2][2], B1[2][2];
    const char* cA = d.A + a_base(d, cur, tstepA); const char* cB = d.Bt + (size_t)cur.pn * tstepB;
    {
        const char* cA1 = cA + a_koff(d, 1);
        PG8_STAGE(PG8_SB(0, 0), cB, voffB); PG8_STAGE(PG8_SB(0, 1), cB + hstepB, voffB); PG8_STAGE(PG8_SA(0, 0), cA, voffA); PG8_STAGE(PG8_SA(0, 1), cA + hstepA, voffA);
        if (wr == 1) PG8_BAR;
        PG8_WAIT_V(2); PG8_BAR;
        PG8_STAGE(PG8_SB(1, 0), cB + kstep, voffB); PG8_STAGE(PG8_SA(1, 0), cA1, voffA); PG8_STAGE(PG8_SB(1, 1), cB + hstepB + kstep, voffB);
        PG8_WAIT_V(6); PG8_BAR;
    }
    for (;;) {
        const bool has_next = S.next(ui + 1, nxt);
        const char* nA = has_next ? d.A + a_base(d, nxt, tstepA) : cA; const char* nB = has_next ? d.Bt + (size_t)nxt.pn * tstepB : cB;
        for (int t = 0; t < nt; t += 2) {
            const bool last = (t == nt - 2);
            const char* a1 = cA + a_koff(d, t + 1);
            const char* a2 = last ? nA : cA + a_koff(d, t + 2); const char* b2 = last ? nB : cB + (size_t)(t + 2) * kstep;
            const char* a3 = last ? nA + a_koff(d, 1) : cA + a_koff(d, t + 3); const char* b3 = b2 + kstep;
            PG8_LDB(B0, 0, 0); PG8_LDB(B1, 0, 1); PG8_SCHED; PG8_LDA(At, 0, 0); PG8_STAGE(PG8_SA(1, 1), a1 + hstepA, voffA);
            PG8_WAIT_V(8); PG8_WAIT_L(0); PG8_BAR; PG8_MMA(0, 0, At, B0); PG8_MMA(0, 1, At, B1); PG8_BAR; PG8_SCHED;
            PG8_LDA(At, 0, 1); PG8_STAGE(PG8_SB(0, 0), b2, voffB); PG8_STAGE(PG8_SB(0, 1), b2 + hstepB, voffB); PG8_STAGE(PG8_SA(0, 0), a2, voffA);
            PG8_WAIT_V(8); PG8_WAIT_L(0); PG8_BAR; PG8_MMA(1, 0, At, B0); PG8_MMA(1, 1, At, B1); PG8_BAR; PG8_SCHED;
            PG8_LDB(B0, 1, 0); PG8_LDB(B1, 1, 1); PG8_SCHED; PG8_LDA(At, 1, 0); PG8_STAGE(PG8_SA(0, 1), a2 + hstepA, voffA);
            PG8_WAIT_V(8); PG8_WAIT_L(0); PG8_BAR; PG8_MMA(0, 0, At, B0); PG8_MMA(0, 1, At, B1); PG8_BAR; PG8_SCHED;
            PG8_LDA(At, 1, 1); PG8_STAGE(PG8_SB(1, 0), b3, voffB); PG8_STAGE(PG8_SB(1, 1), b3 + hstepB, voffB); PG8_STAGE(PG8_SA(1, 0), a3, voffA);
            PG8_WAIT_V(8); PG8_WAIT_L(0); PG8_BAR; PG8_MMA(1, 0, At, B0); PG8_MMA(1, 1, At, B1); PG8_BAR; PG8_SCHED;
        }
        if (wr == 0) PG8_BAR;
        run_epi(d, acc, cur, wr, wc, fr, fq);
        if (!has_next) break;
#pragma unroll
        for (int a = 0; a < 2; ++a)
#pragma unroll
            for (int b = 0; b < 2; ++b)
#pragma unroll
                for (int m = 0; m < 4; ++m)
#pragma unroll
                    for (int n = 0; n < 2; ++n) acc[a][b][m][n] = (f32x4){0.f, 0.f, 0.f, 0.f};
        cur = nxt; cA = nA; cB = nB; ++ui;
        if (wr == 1) PG8_BAR;
    }
    PG8_WAIT_V(0);
    PG8_BAR;
#undef PG8_SA
#undef PG8_SB
#undef PG8_STAGE
#undef PG8_LDA
#undef PG8_LDB
#undef PG8_MMA
#undef PG8_WAIT_V
#undef PG8_WAIT_L
#undef PG8_BAR
#undef PG8_SCHED
}
}

namespace att {
constexpr int NW = 8, QBLK = 32, KVBLK = 64, QB = 256, NKT = 65;
constexpr int KROW = 400;
constexpr int SHM_V = 64 * 128 * 2, SHM_K = 64 * KROW;
constexpr int LDS_QR = 2 * SHM_V + 2 * SHM_K + NW * 64 * 4, QR_ROW = 272, QR_WAVE = 32 * QR_ROW;
constexpr int LDS_NEED = LDS_QR + NW * QR_WAVE;
constexpr float SCALE = 0.07216878364870323f;
constexpr float THR = 8.f;
#define KSWZ(row, colB) ((row) * KROW + (colB))
#define SBAR() __builtin_amdgcn_sched_barrier(0)
__device__ __forceinline__ int v_st(int k, int c) { const int kk = (k & ~0xC) | ((k & 4) << 1) | ((k & 8) >> 1); return ((kk >> 3) * 4 + (c >> 5)) * 512 + ((kk & 7) * 32 + (c & 31)) * 2; }
__device__ __forceinline__ int v_rd_base(int lane) { return ((lane & 3) << 3) | (((lane >> 2) & 3) << 6) | (((lane >> 4) & 1) << 5) | (((lane >> 5) & 1) << 8); }
constexpr int v_rd_off(int d0, int ks, int half) { return d0 * 512 + ks * 4096 + half * 2048; }
__device__ __forceinline__ int crow(int r, int hi) { return (r & 3) + 8 * (r >> 2) + 4 * hi; }
__device__ __forceinline__ bf16x8 ld8(const bf16_t* p) { return *reinterpret_cast<const bf16x8*>(p); }

__device__ __forceinline__ void mask_tile(f32x16& p0, f32x16& p1, int dq) {
    const float NEG = -__builtin_inff();
#pragma unroll
    for (int r = 0; r < 16; ++r) {
        const int c = (r & 3) + 8 * (r >> 2);
        if (dq - c < 0) p0[r] = NEG;
        if (dq - c - 32 < 0) p1[r] = NEG;
    }
}
__device__ __forceinline__ void partialSM(f32x16& p0, f32x16& p1, float& m_reg, float& mn, float& alpha) {
    float pmax = p0[0];
#pragma unroll
    for (int r = 1; r < 16; ++r) pmax = fmaxf(pmax, p0[r]);
#pragma unroll
    for (int r = 0; r < 16; ++r) pmax = fmaxf(pmax, p1[r]);
    { auto rr = __builtin_amdgcn_permlane32_swap(__float_as_uint(pmax), __float_as_uint(pmax), false, false);
      pmax = fmaxf(__uint_as_float(rr[0]), __uint_as_float(rr[1])); }
    constexpr float C2 = 1.4426950408889634f * SCALE;
    if (__builtin_expect(__all((pmax - m_reg) * SCALE <= THR), 1)) { mn = m_reg; alpha = 1.f; }
    else { mn = fmaxf(m_reg, pmax); alpha = __builtin_amdgcn_exp2f((m_reg - mn) * C2); m_reg = mn; }
    const float mnL = -mn * C2;
#pragma unroll
    for (int r = 0; r < 16; ++r) p0[r] = fmaf(p0[r], C2, mnL);
#pragma unroll
    for (int r = 0; r < 16; ++r) p1[r] = fmaf(p1[r], C2, mnL);
#pragma unroll
    for (int r = 0; r < 16; ++r) p0[r] = __builtin_amdgcn_exp2f(p0[r]);
}
__device__ __forceinline__ void finishSM(f32x16& p0, f32x16& p1, float alpha, float& l_reg, bf16x8& pa0, bf16x8& pa1, bf16x8& pa2, bf16x8& pa3) {
#pragma unroll
    for (int r = 0; r < 16; ++r) p1[r] = __builtin_amdgcn_exp2f(p1[r]);
    float ps = 0;
#pragma unroll
    for (int r = 0; r < 16; ++r) ps += p0[r];
#pragma unroll
    for (int r = 0; r < 16; ++r) ps += p1[r];
    { auto rr = __builtin_amdgcn_permlane32_swap(__float_as_uint(ps), __float_as_uint(ps), false, false);
      ps = __uint_as_float(rr[0]) + __uint_as_float(rr[1]); }
    l_reg = l_reg * alpha + ps;
#define PK4(P, B_, OUT) do { unsigned a0 = cvt_pk_bf16(P[B_+0], P[B_+1]), a1 = cvt_pk_bf16(P[B_+2], P[B_+3]);                          \
        unsigned b0 = cvt_pk_bf16(P[B_+4], P[B_+5]), b1 = cvt_pk_bf16(P[B_+6], P[B_+7]);                                             \
        auto r0 = __builtin_amdgcn_permlane32_swap(a0, b0, false, false); auto r1 = __builtin_amdgcn_permlane32_swap(a1, b1, false, false); \
        u32x4 w = {r0[0], r1[0], r0[1], r1[1]}; OUT = *reinterpret_cast<bf16x8*>(&w); } while (0)
    PK4(p0, 0, pa0); PK4(p0, 8, pa1); PK4(p1, 0, pa2); PK4(p1, 8, pa3);
#undef PK4
}
template <int KB>
__device__ __forceinline__ void qkt(f32x16& p0, f32x16& p1, const char* K_lds, int r32, int hi, const bf16x8* qr, const char* qbase) {
    p0 = f32x16{}; p1 = f32x16{};
    const char* kbp = K_lds + KB * SHM_K + r32 * KROW + hi * 16;
#pragma unroll
    for (int d0 = 0; d0 < 12; ++d0) { const char* a = kbp + d0 * 32;
        bf16x8 b0 = *reinterpret_cast<const bf16x8*>(a);
        bf16x8 b1 = *reinterpret_cast<const bf16x8*>(a + 32 * KROW);
        const bf16x8 qf = d0 < 4 ? qr[d0 & 3] : *reinterpret_cast<const bf16x8*>(qbase + (d0 - 4) * 32);
        p0 = __builtin_amdgcn_mfma_f32_32x32x16_bf16(b0, qf, p0, 0, 0, 0);
        p1 = __builtin_amdgcn_mfma_f32_32x32x16_bf16(b1, qf, p1, 0, 0, 0); }
}
template <int VB>
__device__ __forceinline__ void pv_tile(f32x16* o, int vb0, bf16x8 pa0, bf16x8 pa1, bf16x8 pa2, bf16x8 pa3) {
#define TRRD(dst, off) asm volatile("ds_read_b64_tr_b16 %0, %1 offset:%2" : "=&v"(dst) : "v"(vb0), "i"(off) : "memory")
#define PV_D0(d0) do { s16x4 l0, l1, l2, l3, h0, h1, h2, h3; constexpr int b_ = VB * SHM_V + v_rd_off(d0, 0, 0); \
        TRRD(l0, b_); TRRD(h0, b_ + 2048); TRRD(l1, b_ + 4096); TRRD(h1, b_ + 6144); TRRD(l2, b_ + 8192); TRRD(h2, b_ + 10240); TRRD(l3, b_ + 12288); TRRD(h3, b_ + 14336); \
        asm volatile("s_waitcnt lgkmcnt(0)" ::: "memory"); SBAR();   \
        o[d0] = __builtin_amdgcn_mfma_f32_32x32x16_bf16(pa0, (bf16x8){l0[0], l0[1], l0[2], l0[3], h0[0], h0[1], h0[2], h0[3]}, o[d0], 0, 0, 0);   \
        o[d0] = __builtin_amdgcn_mfma_f32_32x32x16_bf16(pa1, (bf16x8){l1[0], l1[1], l1[2], l1[3], h1[0], h1[1], h1[2], h1[3]}, o[d0], 0, 0, 0);   \
        o[d0] = __builtin_amdgcn_mfma_f32_32x32x16_bf16(pa2, (bf16x8){l2[0], l2[1], l2[2], l2[3], h2[0], h2[1], h2[2], h2[3]}, o[d0], 0, 0, 0);   \
        o[d0] = __builtin_amdgcn_mfma_f32_32x32x16_bf16(pa3, (bf16x8){l3[0], l3[1], l3[2], l3[3], h3[0], h3[1], h3[2], h3[3]}, o[d0], 0, 0, 0); } while (0)
    PV_D0(0); PV_D0(1); PV_D0(2); PV_D0(3);
#undef PV_D0
#undef TRRD
}
static_assert(LDS_NEED <= 155648, "attention LDS");
struct Ref { int b, h, P0; };
struct Tens { unsigned char* ws; };
struct Seam { bf16x8 qr[12]; bf16x8 st_v0, st_v1, st_k0, st_k1, st_k2; };
#define VMW() asm volatile("s_waitcnt vmcnt(0)" ::: "memory")
#define VMWN(n) asm volatile("s_waitcnt vmcnt(%0)" :: "i"(n) : "memory")
#define SLOAD(R_, k0) do { const size_t tr_ = (size_t)tokrow((R_).b, (k0) + srow); const bf16_t* kp_ = (const bf16_t*)(T.ws + OFF_KF) + tr_ * 3072 + (R_).h * 192 + c0 * 8; const bf16_t* vp_ = (const bf16_t*)(T.ws + OFF_V) + tr_ * 2048 + (R_).h * 128 + c0 * 8; \
        S.st_v0 = ld8(vp_); S.st_v1 = ld8(vp_ + 64); S.st_k0 = ld8(kp_); S.st_k1 = ld8(kp_ + 64); S.st_k2 = ld8(kp_ + 128); } while (0)
#define SWRITE_HK(bf) do { *(bf16x8*)(K_lds + (bf) * SHM_K + kws) = S.st_k0; *(bf16x8*)(K_lds + (bf) * SHM_K + kws + 128) = S.st_k1; *(bf16x8*)(K_lds + (bf) * SHM_K + kws + 256) = S.st_k2; } while (0)
#define SWRITE_HV(bf) do { *(bf16x8*)(V_lds + (bf) * SHM_V + vst0) = S.st_v0; *(bf16x8*)(V_lds + (bf) * SHM_V + vst0 + 1024) = S.st_v1; } while (0)
#define SWRITE_H(bf) do { SWRITE_HV(bf); SWRITE_HK(bf); } while (0)
#define QLOAD(R_) do { const size_t qrow_ = (size_t)tokrow((R_).b, (R_).P0 + wid * QBLK + r32); const bf16_t* qp_ = (const bf16_t*)(T.ws + OFF_Q) + qrow_ * 3072 + (R_).h * 192 + hi * 8; \
        _Pragma("unroll") for (int d0 = 0; d0 < 12; ++d0) S.qr[d0] = ld8(qp_ + d0 * 16); } while (0)

__device__ __forceinline__ void attn_prime(const Ref& cur, const Tens& T, char* lds, Seam& S) {
    const int tid = opaque_tid(), wid = __builtin_amdgcn_readfirstlane(tid >> 6), lane = tid & 63, r32 = lane & 31, hi = lane >> 5;
    const int srow = tid >> 3, c0 = tid & 7, kws = KSWZ(srow, c0 * 16); char* K_lds = lds + 2 * SHM_V;
    QLOAD(cur);
    SLOAD(cur, 0); VMW(); SWRITE_HK(0);
    __syncthreads();
}
__device__ __forceinline__ void attn_block(const Ref& cur, const Ref& nxt, const Tens& T, char* lds, Seam& S, bool nostore) {
    const int tid = opaque_tid(), wid = __builtin_amdgcn_readfirstlane(tid >> 6), lane = tid & 63, r32 = lane & 31, hi = lane >> 5;
    int j_hi = (cur.P0 + QB - 1) / KVBLK + 1; if (j_hi > NKT) j_hi = NKT;
    if (cur.P0 == 0) j_hi = 1;
    const int NT = j_hi;
    const int qlo = cur.P0 + wid * QBLK, qm = qlo + r32 - 4 * hi;
    char* V_lds = lds; char* K_lds = lds + 2 * SHM_V;
    float* ws = (float*)(lds + 2 * SHM_V + 2 * SHM_K) + wid * 64; float* li_l = ws, * al_l = ws + 32;
    float m_reg = -1e30f, l_reg = 0; f32x16 o[4] = {};
    const int srow = tid >> 3, c0 = tid & 7, vst0 = v_st(srow, c0 * 8), kws = KSWZ(srow, c0 * 16);
    const int vb0 = (int)(uintptr_t)V_lds + v_rd_base(lane);
#define RESC(a) do { if (__any((a) < 1.f)) { if (hi == 0) al_l[r32] = (a); asm volatile("s_waitcnt lgkmcnt(0)" ::: "memory");              \
                     _Pragma("unroll") for (int d_ = 0; d_ < 4; ++d_) _Pragma("unroll") for (int r = 0; r < 16; ++r) o[d_][r] *= al_l[crow(r, hi)]; } } while (0)
#define KBASE(t) ((t) * KVBLK)
#define MASKT(P0_, P1_, t) do { const int kb_ = KBASE(t); if (kb_ + KVBLK - 1 > qlo) mask_tile(P0_, P1_, qm - kb_); } while (0)
    f32x16 pA0, pA1, pB0, pB1; float mnA, mnB, alA, alB; bf16x8 pa0, pa1, pa2, pa3;
    char* qbase = lds + LDS_QR + wid * QR_WAVE + r32 * QR_ROW + hi * 16;
#pragma unroll
    for (int j = 0; j < 8; ++j) *(bf16x8*)(qbase + j * 32) = S.qr[4 + j];
    SBAR();
    SWRITE_HV(0); SBAR();
    if (NT > 1) { SLOAD(cur, KBASE(1)); }
    SBAR(); qkt<0>(pA0, pA1, K_lds, r32, hi, S.qr, qbase);
    MASKT(pA0, pA1, 0); partialSM(pA0, pA1, m_reg, mnA, alA);
    if (NT > 1) { VMW(); SWRITE_H(1); }
    __syncthreads();
#define HALF_STEP(PX0, PX1, mnX, alX, PY0, PY1, alY, t, KB, VB, SB) do {                                                      \
        SBAR(); qkt<KB>(PX0, PX1, K_lds, r32, hi, S.qr, qbase);                                                                      \
        finishSM(PY0, PY1, alY, l_reg, pa0, pa1, pa2, pa3); SBAR();                                                           \
        if ((t) + 1 < NT) { SLOAD(cur, KBASE((t) + 1)); SBAR(); }                                                             \
        pv_tile<VB>(o, vb0, pa0, pa1, pa2, pa3); MASKT(PX0, PX1, (t)); partialSM(PX0, PX1, m_reg, mnX, alX);                  \
        __syncthreads();                                                                                                      \
        if ((t) + 1 < NT) { VMW(); SWRITE_H(SB); }                                                                            \
        RESC(alX); __syncthreads(); } while (0)
    for (int t = 1; t + 1 < NT; t += 2) {
        HALF_STEP(pB0, pB1, mnB, alB, pA0, pA1, alA, t, 1, 0, 0);
        HALF_STEP(pA0, pA1, mnA, alA, pB0, pB1, alB, t + 1, 0, 1, 1);
    }
    const bool even = (NT & 1) == 0;
    if (even) { SBAR(); qkt<1>(pB0, pB1, K_lds, r32, hi, S.qr, qbase); SBAR(); }
    SLOAD(nxt, 0); SBAR();
    QLOAD(nxt);
    SBAR();
    finishSM(pA0, pA1, alA, l_reg, pa0, pa1, pa2, pa3); SBAR();
    pv_tile<0>(o, vb0, pa0, pa1, pa2, pa3);
    if (even) { MASKT(pB0, pB1, NT - 1); partialSM(pB0, pB1, m_reg, mnB, alB); __syncthreads(); RESC(alB);
        finishSM(pB0, pB1, alB, l_reg, pa0, pa1, pa2, pa3); SBAR(); pv_tile<1>(o, vb0, pa0, pa1, pa2, pa3); }
    SBAR(); VMWN(12); SWRITE_HK(0); SBAR();
    if (hi == 0) li_l[r32] = l_reg; asm volatile("s_waitcnt lgkmcnt(0)" ::: "memory");
    float rli[16];
#pragma unroll
    for (int r = 0; r < 16; ++r) rli[r] = __builtin_amdgcn_rcpf(li_l[crow(r, hi)]);
    {
        char* stg = lds + LDS_QR + wid * QR_WAVE;
#pragma unroll
        for (int r = 0; r < 16; ++r) { const int orow = crow(r, hi);
#pragma unroll
            for (int d0 = 0; d0 < 4; ++d0) { const float v = o[d0][r] * rli[r];
                *(bf16_t*)(stg + orow * QR_ROW + (d0 * 32 + r32) * 2) = (bf16_t)(cvt_pk_bf16(v, 0.f) & 0xffffu); } }
        asm volatile("s_waitcnt lgkmcnt(0)" ::: "memory");
#pragma unroll
        for (int i = 0; i < 8; ++i) { const int row = i * 4 + (lane >> 4), ch = lane & 15; const int pos = cur.P0 + wid * QBLK + row;
            const u32x4 w = *(const u32x4*)(stg + row * QR_ROW + ch * 16);
            const bool ok = (cur.P0 != 0 || pos < NMETA) && !nostore;
            if (ok) *(u32x4*)((bf16_t*)(T.ws + OFF_Q) + (size_t)tokrow(cur.b, pos) * 3072 + cur.h * 192 + ch * 8) = w; }
        asm volatile("s_waitcnt lgkmcnt(0)" ::: "memory");
    }
    __syncthreads();
#undef RESC
#undef KBASE
#undef MASKT
#undef HALF_STEP
}
__device__ __forceinline__ Ref make_ref(int L, int pass) {
    Ref r;
    if (L < 512) { const int bh = L >> 3, x = L & 7; const int qb = pass ? 15 - x : x; r.b = bh >> 4; r.h = bh & 15; r.P0 = NMETA + qb * QB; }
    else { r.b = 0; r.h = L - 512; r.P0 = 0; }
    return r;
}
__device__ __forceinline__ void attn_phase(char* lds, const Tens& T, int vcu, int G, bool nostore, bool with_meta) {
    const int TOTAL = with_meta ? 512 + 16 : 512;
    int L = vcu; if (L >= TOTAL) return;
    int pass = 0;
    Ref cur = make_ref(L, 0);
    Seam S;
    attn_prime(cur, T, lds, S);
    for (;;) {
        const bool more_pass = (pass == 0 && L < 512), more_item = L + G < TOTAL, last = !more_pass && !more_item;
        int passn = pass + 1, Ln = L;
        if (!more_pass) { passn = 0; Ln = more_item ? L + G : L; }
        const Ref nxt = last ? cur : make_ref(Ln, passn);
        attn_block(cur, nxt, T, lds, S, nostore);
        if (last) break;
        cur = nxt; pass = passn; L = Ln;
    }
}
#undef SLOAD
#undef SWRITE_HK
#undef SWRITE_HV
#undef SWRITE_H
#undef QLOAD
#undef VMW
#undef VMWN
#undef SBAR
}

struct Params {
    const float* x; const float* meta; const float* attn_norm; const float* w_in; const float* conv_w; const float* q_lat_norm; const float* kv_lat_norm;
    const float* w_uq; const float* w_ukv; const float* q_norm; const float* k_norm; const float* pool_w; const float* pool_scale;
    const float* w_a; const float* w_b; const float* w_c; const float* w_o; const float* mlp_norm; const float* w_up; const float* w_down;
    float* out; unsigned char* ws;
};

struct MatDesc { const float* W; int ldw, K, N; bf16_t* WT; const float* gain; const float* colscale; int split; int splitadd; };
__device__ __forceinline__ void convert_mat(const MatDesc& m, LAS float* scr, int gw, int NGW, int lane, int& base) {
    const int nblk = m.N / 64, items = (m.K / 64) * nblk;
    int it = gw - (base % NGW); if (it < 0) it += NGW;
    base += items;
    if (it >= items) return;
    const int cl = (lane & 15) * 4, kr = lane >> 4, c = lane & 7;
    f32x4 v[16]; float g[16]; f32x4 cs4;
#define CV_LOAD(it_) do { const int kb_ = (it_) / nblk, n0_ = ((it_) % nblk) * 64, k0_ = kb_ * 64; \
        cs4 = m.colscale ? *(const f32x4*)(m.colscale + n0_ + cl) : (f32x4){1.f, 1.f, 1.f, 1.f}; \
        _Pragma("unroll") for (int i = 0; i < 16; ++i) v[i] = __builtin_nontemporal_load((const f32x4*)(m.W + (size_t)(k0_ + i * 4 + kr) * m.ldw + n0_ + cl)); \
        _Pragma("unroll") for (int i = 0; i < 16; ++i) g[i] = m.gain ? m.gain[k0_ + i * 4 + kr] : 1.f; } while (0)
    CV_LOAD(it);
    for (;;) {
        const int kb = it / nblk, n0 = (it % nblk) * 64, k0 = kb * 64;
        const int dst_row = n0 >= m.split ? n0 + m.splitadd : n0;
#pragma unroll
        for (int i = 0; i < 16; ++i) { const int kk = i * 4 + kr; const f32x4 x = v[i] * cs4 * g[i];
            LAS float* dl = scr + kk * 65 + cl; dl[0] = x[0]; dl[1] = x[1]; dl[2] = x[2]; dl[3] = x[3]; }
        asm volatile("s_waitcnt lgkmcnt(0)" ::: "memory");
        const int nit = it + NGW; const bool more = nit < items;
        if (more) CV_LOAD(nit);
#pragma unroll
        for (int j = 0; j < 8; ++j) { const int n = (lane >> 3) + 8 * j; const LAS float* sl = scr + (8 * c) * 65 + n;
            u32x4 o; o.x = cvt_pk_bf16(sl[0 * 65], sl[1 * 65]); o.y = cvt_pk_bf16(sl[2 * 65], sl[3 * 65]); o.z = cvt_pk_bf16(sl[4 * 65], sl[5 * 65]); o.w = cvt_pk_bf16(sl[6 * 65], sl[7 * 65]);
            *(u32x4*)(m.WT + (size_t)(dst_row + n) * m.K + k0 + 8 * c) = o; }
        asm volatile("s_waitcnt lgkmcnt(0)" ::: "memory");
        if (!more) break;
        it = nit;
    }
#undef CV_LOAD
}
__device__ __forceinline__ void convert_weights(const Params& P, int l, LAS unsigned char* lds, int gw, int NGW, int wave, int lane, int part) {
    LAS float* scr = (LAS float*)(lds + wave * 16640);
    unsigned char* ws = P.ws; int base = 0;
    const int BIG = 1 << 30;
    MatDesc m;
    if (part != 1) {
    m = MatDesc{P.w_in + (size_t)l * DM * DIN, DIN, DM, DIN, (bf16_t*)(ws + OFF_WIN), P.attn_norm + l * DM, nullptr, N1SRC, N1 - N1SRC}; convert_mat(m, scr, gw, NGW, lane, base);
    m = MatDesc{P.w_uq + (size_t)l * 512 * 3072, 3072, 512, 3072, (bf16_t*)(ws + OFF_WUQ), P.q_lat_norm + l * 512, nullptr, BIG, 0}; convert_mat(m, scr, gw, NGW, lane, base);
    m = MatDesc{P.w_ukv + (size_t)l * 512 * 4096, 4096, 512, 4096, (bf16_t*)(ws + OFF_WUKV), P.kv_lat_norm + l * 512, nullptr, BIG, 0}; convert_mat(m, scr, gw, NGW, lane, base);
    for (int g = 0; g < 4; ++g) {
        m = MatDesc{P.pool_w + (size_t)l * 4 * 65536 + (size_t)g * 65536, 256, 256, 256, (bf16_t*)(ws + OFF_WPOOL) + (size_t)g * 65536, nullptr, P.pool_scale + l * 1024 + g * 256, BIG, 0}; convert_mat(m, scr, gw, NGW, lane, base); }
    m = MatDesc{P.w_a + (size_t)l * 1024 * 2048, 2048, 1024, 2048, (bf16_t*)(ws + OFF_WA), nullptr, nullptr, BIG, 0}; convert_mat(m, scr, gw, NGW, lane, base);
    m = MatDesc{P.w_b + (size_t)l * 2048 * 2048, 2048, 2048, 2048, (bf16_t*)(ws + OFF_WB), nullptr, nullptr, BIG, 0}; convert_mat(m, scr, gw, NGW, lane, base);
    m = MatDesc{P.w_c + (size_t)l * 1024 * 2048, 2048, 1024, 2048, (bf16_t*)(ws + OFF_WC), nullptr, nullptr, BIG, 0}; convert_mat(m, scr, gw, NGW, lane, base);
    { u32x4* z = (u32x4*)((bf16_t*)(ws + OFF_WIN) + (size_t)N1SRC * DM); const int n16 = (N1 - N1SRC) * DM * 2 / 16;
      for (int i = gw * 64 + lane; i < n16; i += NGW * 64) z[i] = (u32x4){0u, 0u, 0u, 0u}; }
    }
    if (part != 0) {
    m = MatDesc{P.w_o + (size_t)l * 2048 * 2048, 2048, 2048, 2048, (bf16_t*)(ws + OFF_WO), nullptr, nullptr, BIG, 0}; convert_mat(m, scr, gw, NGW, lane, base);
    m = MatDesc{P.w_up + (size_t)l * DM * DFF, DFF, DM, DFF, (bf16_t*)(ws + OFF_WUP), P.mlp_norm + l * DM, nullptr, BIG, 0}; convert_mat(m, scr, gw, NGW, lane, base);
    m = MatDesc{P.w_down + (size_t)l * DFF * DM, DM, DFF, DM, (bf16_t*)(ws + OFF_WDN), nullptr, nullptr, BIG, 0}; convert_mat(m, scr, gw, NGW, lane, base);
    }
}

__device__ __forceinline__ void prep_phase(const Params& P, int gw, int NGW, int lane) {
    unsigned char* ws = P.ws;
    float* cs = (float*)(ws + OFF_CS);
    for (int i = gw * 64 + lane; i < TT * 32; i += NGW * 64) {
        const int t = i >> 5, f = i & 31;
        const float inv = exp2f(-(float)f * (13.287712379549449f / 32.f));
        const float ang = (float)t * inv;
        const double a = (double)ang; const double k = rint(a * 0.15915494309189535); const float rr = (float)(a - k * 6.283185307179586);
        cs[i] = __cosf(rr); cs[TT * 32 + i] = __sinf(rr);
    }
    float* ss = (float*)(ws + OFF_SS);
    for (int i = gw * 64 + lane; i < 3 * MP; i += NGW * 64) ss[MP + i] = 0.f;
    bf16_t* XB = (bf16_t*)(ws + OFF_XB); float* xm = (float*)(ws + OFF_XM);
#define PREP_SRC(r_) ((r_) < MREAL ? P.x + (size_t)(r_) * DM : ((r_) < MVALID ? P.meta + (size_t)((r_) - MREAL) * DM : (const float*)nullptr))
#define PREP_LOAD(buf, r_) do { const float* src_ = PREP_SRC(r_); _Pragma("unroll") for (int j = 0; j < 8; ++j) \
        buf[j] = src_ ? __builtin_nontemporal_load((const f32x4*)(src_ + (j * 64 + lane) * 4)) : (f32x4){0.f, 0.f, 0.f, 0.f}; } while (0)
#define PREP_STORE(buf, r_) do { float s_ = 0.f; _Pragma("unroll") for (int j = 0; j < 8; ++j) { const f32x4 v = buf[j]; \
        s_ += (v[0] * v[0] + v[1] * v[1]) + (v[2] * v[2] + v[3] * v[3]); \
        u32x2 w; w.x = cvt_pk_bf16(v[0], v[1]); w.y = cvt_pk_bf16(v[2], v[3]); \
        *(u32x2*)(XB + (size_t)(r_) * DM + (j * 64 + lane) * 4) = w; \
        if ((r_) >= MREAL) *(f32x4*)(xm + (size_t)((r_) - MREAL) * DM + (j * 64 + lane) * 4) = v; } \
        s_ = wave_sum(s_); if (lane == 0) ss[(r_)] = s_; } while (0)
    f32x4 va[8], vb[8];
    int r = gw;
    if (r < MP) {
        PREP_LOAD(va, r);
        for (;;) {
            const int r1 = r + NGW; if (r1 < MP) PREP_LOAD(vb, r1);
            PREP_STORE(va, r);
            if (r1 >= MP) break;
            const int r2 = r1 + NGW; if (r2 < MP) PREP_LOAD(va, r2);
            PREP_STORE(vb, r1);
            if (r2 >= MP) break;
            r = r2;
        }
    }
#undef PREP_SRC
#undef PREP_LOAD
#undef PREP_STORE
}

__device__ __forceinline__ int prevrow(int r, int t, int j) { return (r < MREAL && (r & (SEQ - 1)) < j) ? MREAL + t - j : r - j; }
__device__ __forceinline__ void unpack8(const u32x4 w, float* e) { e[0] = bflo(w.x); e[1] = bfhi(w.x); e[2] = bflo(w.y); e[3] = bfhi(w.y); e[4] = bflo(w.z); e[5] = bfhi(w.z); e[6] = bflo(w.w); e[7] = bfhi(w.w); }
__device__ __forceinline__ u32x4 pack8f(const float* e) { u32x4 w; w.x = cvt_pk_bf16(e[0], e[1]); w.y = cvt_pk_bf16(e[2], e[3]); w.z = cvt_pk_bf16(e[4], e[5]); w.w = cvt_pk_bf16(e[6], e[7]); return w; }
__device__ __forceinline__ float ssq8(const u32x4 w) { float e[8]; unpack8(w, e); return (e[0] * e[0] + e[1] * e[1]) + (e[2] * e[2] + e[3] * e[3]) + (e[4] * e[4] + e[5] * e[5]) + (e[6] * e[6] + e[7] * e[7]); }
__device__ __forceinline__ void mix_phase(const Params& P, int l, int gw, int NGW, int lane, LAS unsigned char* lds) {
    unsigned char* ws = P.ws;
    bf16_t* P1 = (bf16_t*)(ws + OFF_P1); bf16_t* Q = (bf16_t*)(ws + OFF_Q); bf16_t* KF = (bf16_t*)(ws + OFF_KF); bf16_t* V = (bf16_t*)(ws + OFF_V); const bf16_t* Z = (const bf16_t*)(ws + OFF_Z);
    const float* cs = (const float*)(ws + OFF_CS);
    LAS float* Lq = (LAS float*)lds; LAS float* Lk = Lq + 192; LAS float* Lc = Lk + 192;
    for (int i = threadIdx.x; i < 192; i += 512) { Lq[i] = P.q_norm[l * DQK + i]; Lk[i] = P.k_norm[l * DQK + i]; }
    for (int i = threadIdx.x; i < 3072; i += 512) Lc[i] = P.conv_w[l * 3072 + i];
    __syncthreads();
    const int sub = lane & 3, h = lane >> 2;
    int eoff[6];
#pragma unroll
    for (int j = 0; j < 4; ++j) eoff[j] = sub * 8 + 32 * j;
    eoff[4] = 128 + sub * 8; eoff[5] = 160 + sub * 8;
    for (int r = gw; r < MVALID; r += NGW) {
        int t; if (r < MREAL) t = NMETA + (r & (SEQ - 1)); else t = r - MREAL;
        bf16_t* p1 = P1 + (size_t)r * N1;
        bf16_t* qp = Q + (size_t)r * 3072 + h * 192; bf16_t* kp = KF + (size_t)r * 3072 + h * 192; bf16_t* vp = V + (size_t)r * 2048 + h * 128;
        const u32x4 ql = *(const u32x4*)(p1 + C_QLAT + lane * 8), kl = *(const u32x4*)(p1 + C_KVLAT + lane * 8);
        u32x4 qv[6], kv[6], vv[4];
#pragma unroll
        for (int j = 0; j < 6; ++j) qv[j] = *(const u32x4*)(qp + eoff[j]);
#pragma unroll
        for (int j = 0; j < 4; ++j) kv[j] = *(const u32x4*)(kp + eoff[j]);
        kv[4] = *(const u32x4*)(p1 + C_KROPE + sub * 8); kv[5] = *(const u32x4*)(p1 + C_KROPE + 32 + sub * 8);
#pragma unroll
        for (int j = 0; j < 4; ++j) vv[j] = *(const u32x4*)(vp + eoff[j]);
        const f32x4 c0 = *(const f32x4*)(cs + t * 32 + sub * 8), c1 = *(const f32x4*)(cs + t * 32 + sub * 8 + 4);
        const f32x4 s0 = *(const f32x4*)(cs + TT * 32 + t * 32 + sub * 8), s1 = *(const f32x4*)(cs + TT * 32 + t * 32 + sub * 8 + 4);
        const float cc[8] = {c0[0], c0[1], c0[2], c0[3], c1[0], c1[1], c1[2], c1[3]}, sn[8] = {s0[0], s0[1], s0[2], s0[3], s1[0], s1[1], s1[2], s1[3]};
        const float aq = __builtin_amdgcn_rsqf(wave_sum(ssq8(ql)) * (1.f / 512.f) + EPS);
        const float akv = __builtin_amdgcn_rsqf(wave_sum(ssq8(kl)) * (1.f / 512.f) + EPS);
        {
            float e[6][8]; float ss = 0.f;
#pragma unroll
            for (int j = 0; j < 6; ++j) { unpack8(qv[j], e[j]);
#pragma unroll
                for (int i = 0; i < 8; ++i) { e[j][i] *= aq; ss += e[j][i] * e[j][i]; } }
            ss += __shfl_xor(ss, 1); ss += __shfl_xor(ss, 2);
            const float rn = __builtin_amdgcn_rsqf(ss * (1.f / 192.f) + EPS);
#pragma unroll
            for (int j = 0; j < 6; ++j) { const f32x4 g0 = *(const LAS f32x4*)(Lq + eoff[j]), g1 = *(const LAS f32x4*)(Lq + eoff[j] + 4);
#pragma unroll
                for (int i = 0; i < 4; ++i) { e[j][i] *= rn * g0[i]; e[j][4 + i] *= rn * g1[i]; } }
#pragma unroll
            for (int i = 0; i < 8; ++i) { const float x1 = e[4][i], x2 = e[5][i]; e[4][i] = x1 * cc[i] - x2 * sn[i]; e[5][i] = x2 * cc[i] + x1 * sn[i]; }
#pragma unroll
            for (int j = 0; j < 6; ++j) qv[j] = pack8f(e[j]);
        }
        {
            float e[6][8]; float ss = 0.f;
#pragma unroll
            for (int j = 0; j < 6; ++j) { unpack8(kv[j], e[j]);
#pragma unroll
                for (int i = 0; i < 8; ++i) { if (j < 4) e[j][i] *= akv; ss += e[j][i] * e[j][i]; } }
            ss += __shfl_xor(ss, 1); ss += __shfl_xor(ss, 2);
            const float rn = __builtin_amdgcn_rsqf(ss * (1.f / 192.f) + EPS);
#pragma unroll
            for (int j = 0; j < 6; ++j) { const f32x4 g0 = *(const LAS f32x4*)(Lk + eoff[j]), g1 = *(const LAS f32x4*)(Lk + eoff[j] + 4);
#pragma unroll
                for (int i = 0; i < 4; ++i) { e[j][i] *= rn * g0[i]; e[j][4 + i] *= rn * g1[i]; } }
#pragma unroll
            for (int i = 0; i < 8; ++i) { const float x1 = e[4][i], x2 = e[5][i]; e[4][i] = x1 * cc[i] - x2 * sn[i]; e[5][i] = x2 * cc[i] + x1 * sn[i]; }
#pragma unroll
            for (int j = 0; j < 6; ++j) kv[j] = pack8f(e[j]);
        }
#pragma unroll
        for (int j = 0; j < 4; ++j) { float e[8]; unpack8(vv[j], e);
#pragma unroll
            for (int i = 0; i < 8; ++i) e[i] *= akv;
            vv[j] = pack8f(e); }
        const int rm1 = t >= 1 ? prevrow(r, t, 1) : r, rm2 = t >= 2 ? prevrow(r, t, 2) : r;
        const float f1 = t >= 1 ? 1.f : 0.f, f2 = t >= 2 ? 1.f : 0.f;
        u32x4 cu[2][7];
#pragma unroll
        for (int hc = 0; hc < 2; ++hc) {
            const int ch = hc * 512 + lane * 8;
            const bf16_t* q1 = P1 + (size_t)rm1 * N1; const bf16_t* q2 = P1 + (size_t)rm2 * N1;
            cu[hc][0] = *(const u32x4*)(p1 + ch); cu[hc][1] = *(const u32x4*)(p1 + 2048 + ch);
            cu[hc][2] = *(const u32x4*)(q1 + ch); cu[hc][3] = *(const u32x4*)(q1 + 2048 + ch);
            cu[hc][4] = *(const u32x4*)(q2 + ch); cu[hc][5] = *(const u32x4*)(q2 + 2048 + ch);
            cu[hc][6] = *(const u32x4*)(p1 + 1024 + ch);
        }
#pragma unroll
        for (int j = 0; j < 6; ++j) *(u32x4*)(qp + eoff[j]) = qv[j];
#pragma unroll
        for (int j = 0; j < 6; ++j) *(u32x4*)(kp + eoff[j]) = kv[j];
#pragma unroll
        for (int j = 0; j < 4; ++j) *(u32x4*)(vp + eoff[j]) = vv[j];
        u32x4 co[2];
#pragma unroll
        for (int hc = 0; hc < 2; ++hc) {
            const int ch = hc * 512 + lane * 8;
            float a0[8], a1[8], a2[8], x[8], y[8], bb[8], o[8];
            unpack8(cu[hc][0], x); unpack8(cu[hc][1], y);
#pragma unroll
            for (int i = 0; i < 8; ++i) a0[i] = x[i] * y[i];
            unpack8(cu[hc][2], x); unpack8(cu[hc][3], y);
#pragma unroll
            for (int i = 0; i < 8; ++i) a1[i] = x[i] * y[i] * f1;
            unpack8(cu[hc][4], x); unpack8(cu[hc][5], y);
#pragma unroll
            for (int i = 0; i < 8; ++i) a2[i] = x[i] * y[i] * f2;
            unpack8(cu[hc][6], bb);
            const f32x4 w20 = *(const LAS f32x4*)(Lc + 2048 + ch), w21 = *(const LAS f32x4*)(Lc + 2048 + ch + 4), w10 = *(const LAS f32x4*)(Lc + 1024 + ch), w11 = *(const LAS f32x4*)(Lc + 1024 + ch + 4), w00 = *(const LAS f32x4*)(Lc + ch), w01 = *(const LAS f32x4*)(Lc + ch + 4);
            const float w2[8] = {w20[0], w20[1], w20[2], w20[3], w21[0], w21[1], w21[2], w21[3]}, w1[8] = {w10[0], w10[1], w10[2], w10[3], w11[0], w11[1], w11[2], w11[3]}, w0[8] = {w00[0], w00[1], w00[2], w00[3], w01[0], w01[1], w01[2], w01[3]};
#pragma unroll
            for (int i = 0; i < 8; ++i) o[i] = bb[i] * (w2[i] * a0[i] + w1[i] * a1[i] + w0[i] * a2[i]);
            co[hc] = pack8f(o);
        }
        u32x4 po[2];
#pragma unroll
        for (int hc = 0; hc < 2; ++hc) {
            const int ch = hc * 512 + lane * 8;
            const int wdw = 2 << (hc * 2 + (lane >> 5)); const int cnt = (t + 1) < wdw ? (t + 1) : wdw;
            const u32x4 z0 = *(const u32x4*)(Z + (size_t)r * 1024 + ch);
            float zc[8], acc[8]; unpack8(z0, zc);
#pragma unroll
            for (int i = 0; i < 8; ++i) acc[i] = zc[i];
            if (hc == 0) {
#pragma unroll
                for (int j = 1; j < 4; ++j) if (j < cnt) { float e[8]; unpack8(*(const u32x4*)(Z + (size_t)prevrow(r, t, j) * 1024 + ch), e);
#pragma unroll
                    for (int i = 0; i < 8; ++i) acc[i] += e[i]; }
            } else {
#pragma unroll
                for (int j = 1; j < 16; ++j) if (j < cnt) { float e[8]; unpack8(*(const u32x4*)(Z + (size_t)prevrow(r, t, j) * 1024 + ch), e);
#pragma unroll
                    for (int i = 0; i < 8; ++i) acc[i] += e[i]; }
            }
            const float ic = 1.f / (float)cnt; float o[8];
#pragma unroll
            for (int i = 0; i < 8; ++i) o[i] = acc[i] * ic - zc[i];
            po[hc] = pack8f(o);
        }
#pragma unroll
        for (int hc = 0; hc < 2; ++hc) { const int ch = hc * 512 + lane * 8; *(u32x4*)(p1 + 1024 + ch) = co[hc]; *(u32x4*)(p1 + C_POOL + ch) = po[hc]; }
    }
    __syncthreads();
}

#define XB_TMO      128
#define XB_XCNT(j)  (256  + 64 * (j))
#define XB_XSUB(j)  (1280 + 64 * (j))
#define XB_XGEN(j)  (2304 + 64 * (j))
#define XB_TOP      3328
#define XB_TOPGEN   3392
#define XCD_BAR_WORDS 3456
#define XB_SPIN_CAP (1u << 18)
__device__ __forceinline__ unsigned xb_ld(unsigned* p)              { return __hip_atomic_load(p, __ATOMIC_RELAXED, __HIP_MEMORY_SCOPE_AGENT); }
__device__ __forceinline__ unsigned xb_add(unsigned* p, unsigned v) { return __hip_atomic_fetch_add(p, v, __ATOMIC_RELAXED, __HIP_MEMORY_SCOPE_AGENT); }
__device__ __forceinline__ unsigned xb_xcc_id() { return (unsigned)__builtin_amdgcn_s_getreg((3 << 11) | 20) & 0xFu; }
#define XB_SPIN(cond, bar) do { unsigned _sp = 0; while (cond) { __builtin_amdgcn_s_sleep(1); \
    if ((++_sp & 255u) == 0u) { if (xb_ld(&(bar)[XB_TMO])) break; if (_sp > XB_SPIN_CAP) { atomicAdd(&(bar)[XB_TMO], 1u); break; } } } } while (0)
struct XcdBarrier { unsigned* bar; unsigned x; volatile LAS unsigned* st; };
__device__ __forceinline__ XcdBarrier xcd_barrier_post(unsigned* bar, volatile LAS unsigned* st) {
    XcdBarrier b; b.bar = bar; b.x = xb_xcc_id(); b.st = st;
    if (threadIdx.x == 0) (void)xb_add(&bar[XB_XCNT(b.x)], 1u);
    return b;
}
__device__ __forceinline__ void xcd_barrier_complete(unsigned* bar, unsigned x, unsigned& nloc, unsigned& nx) {
    const unsigned G = gridDim.x * gridDim.y * gridDim.z;
    unsigned sum, cnt, mine, sp = 0u;
    for (;;) {
        sum = 0u; cnt = 0u; mine = 0u;
#pragma unroll
        for (unsigned j = 0; j < 16; ++j) { const unsigned c = xb_ld(&bar[XB_XCNT(j)]); sum += c; cnt += (c > 0u) ? 1u : 0u; mine = (j == x) ? c : mine; }
        if (sum == G) break;
        __builtin_amdgcn_s_sleep(1);
        if ((++sp & 255u) == 0u) { if (xb_ld(&bar[XB_TMO])) break; if (sp > XB_SPIN_CAP) { atomicAdd(&bar[XB_TMO], 1u); break; } }
    }
    nloc = mine > 0u ? mine : 1u; nx = cnt > 0u ? cnt : 1u;
}
__device__ __forceinline__ void xcd_barrier(const XcdBarrier& b) {
    asm volatile("s_waitcnt vmcnt(0)" ::: "memory");
    __syncthreads();
    if (threadIdx.x == 0) {
        unsigned* bar = b.bar;
        __builtin_amdgcn_s_waitcnt(0);
        unsigned nloc = b.st[0], nx = b.st[1];
        if (nloc == 0u) { xcd_barrier_complete(bar, b.x, nloc, nx); b.st[0] = nloc; b.st[1] = nx; }
        const unsigned old = xb_add(&bar[XB_XSUB(b.x)], 1u);
        const unsigned gen = old / nloc;
        if (old + 1u == (gen + 1u) * nloc) {
            __builtin_amdgcn_fence(__ATOMIC_RELEASE, "agent");
            asm volatile("s_waitcnt vmcnt(0)" ::: "memory");
            const unsigned og = xb_add(&bar[XB_TOP], 1u);
            const unsigned tg = og / nx;
            if (og + 1u == (tg + 1u) * nx) xb_add(&bar[XB_TOPGEN], 1u);
            else XB_SPIN(xb_ld(&bar[XB_TOPGEN]) == tg, bar);
            __builtin_amdgcn_fence(__ATOMIC_ACQUIRE, "agent");
            xb_add(&bar[XB_XGEN(b.x)], 1u);
            asm volatile("s_waitcnt vmcnt(0)" ::: "memory");
        } else {
            XB_SPIN(xb_ld(&bar[XB_XGEN(b.x)]) == gen, bar);
            __builtin_amdgcn_fence(__ATOMIC_ACQUIRE, "agent");
            asm volatile("s_waitcnt vmcnt(0)" ::: "memory");
        }
    }
    __syncthreads();
}

__device__ __forceinline__ void fill_desc(pg8::GDesc& d, const Params& P, unsigned char* ws, int l, int gid) {
    bf16_t* P1 = (bf16_t*)(ws + OFF_P1); float* ss = (float*)(ws + OFF_SS);
    d.ws = ws; d.amode = 0; d.epi = 0; d.O = nullptr; d.ldc = 0; d.ss = nullptr; d.ssacc = nullptr; d.Gt = nullptr; d.src = nullptr; d.dst = nullptr; d.act = 0; d.first = 0; d.lastout = 0;
    switch (gid) {
    case 0: d.A = (const char*)(ws + OFF_XB); d.lda = DM; d.Bt = (const char*)(ws + OFF_WIN); d.ldb = DM; d.nt = DM / 64; d.nN = N1 / 256; d.O = P1; d.ldc = N1; d.ss = ss + (2 * l) * MP; break;
    case 1: d.A = (const char*)(P1 + C_QLAT); d.lda = N1; d.Bt = (const char*)(ws + OFF_WUQ); d.ldb = 512; d.nt = 8; d.nN = 12; d.O = (bf16_t*)(ws + OFF_Q); d.ldc = 3072; break;
    case 2: d.A = (const char*)(P1 + C_KVLAT); d.lda = N1; d.Bt = (const char*)(ws + OFF_WUKV); d.ldb = 512; d.nt = 8; d.nN = 16; d.epi = 1; break;
    case 3: d.A = (const char*)(P1 + C_POOL); d.lda = N1; d.Bt = (const char*)(ws + OFF_WPOOL); d.ldb = 256; d.nt = 4; d.nN = 4; d.amode = 1; d.O = (bf16_t*)(ws + OFF_Z); d.ldc = 1024; break;
    case 4: d.A = (const char*)(ws + OFF_XB); d.lda = DM; d.Bt = (const char*)(ws + OFF_WIN + (size_t)N1 * DM * 2); d.ldb = DM; d.nt = DM / 64; d.nN = NG / 256; d.O = (bf16_t*)(ws + OFF_G); d.ldc = NG; d.ss = ss + (2 * l) * MP; d.act = 1; break;
    case 5: d.A = (const char*)(P1 + 1024); d.lda = N1; d.Bt = (const char*)(ws + OFF_WA); d.ldb = 1024; d.nt = 16; d.nN = 8; d.epi = 2; d.O = P1 + 2048; d.ldc = N1; d.Gt = (const bf16_t*)(ws + OFF_G); d.first = 1; break;
    case 6: d.A = (const char*)(ws + OFF_Q); d.lda = 3072; d.Bt = (const char*)(ws + OFF_WB); d.ldb = 2048; d.nt = 32; d.nN = 8; d.amode = 2; d.epi = 2; d.O = P1 + 2048; d.ldc = N1; d.Gt = (const bf16_t*)(ws + OFF_G) + 2048; break;
    case 7: d.A = (const char*)(P1 + C_POOL); d.lda = N1; d.Bt = (const char*)(ws + OFF_WC); d.ldb = 1024; d.nt = 16; d.nN = 8; d.epi = 2; d.O = P1 + 2048; d.ldc = N1; d.Gt = (const bf16_t*)(ws + OFF_G) + 4096; break;
    case 8: d.A = (const char*)(P1 + 2048); d.lda = N1; d.Bt = (const char*)(ws + OFF_WO); d.ldb = 2048; d.nt = 32; d.nN = 8; d.epi = 3; d.src = l == 0 ? P.x : P.out; d.dst = P.out; d.ssacc = ss + (2 * l + 1) * MP; break;
    case 9: d.A = (const char*)(ws + OFF_XB); d.lda = DM; d.Bt = (const char*)(ws + OFF_WUP); d.ldb = DM; d.nt = DM / 64; d.nN = DFF / 256; d.O = (bf16_t*)(ws + OFF_H); d.ldc = DFF; d.ss = ss + (2 * l + 1) * MP; d.act = 2; break;
    default: d.A = (const char*)(ws + OFF_H); d.lda = DFF; d.Bt = (const char*)(ws + OFF_WDN); d.ldb = DFF; d.nt = DFF / 64; d.nN = 8; d.epi = 3; d.src = P.out; d.dst = P.out; d.ssacc = l == 0 ? ss + 2 * MP : nullptr; d.lastout = l; break;
    }
}

__global__ void __launch_bounds__(512, 2) fwd_megakernel(Params P) {
    extern __shared__ __attribute__((aligned(16))) unsigned char lds[];
    cg::grid_group grid = cg::this_grid();
    volatile LAS unsigned* bst = (volatile LAS unsigned*)((LAS unsigned char*)lds + LDS_BAR_OFF);
    if (threadIdx.x < 16) bst[threadIdx.x] = 0u;
    __syncthreads();
    const XcdBarrier bar = xcd_barrier_post((unsigned*)(P.ws + OFF_BAR), bst);
    {
        const int tid = opaque_tid(), lane = tid & 63, wave = __builtin_amdgcn_readfirstlane(tid >> 6);
        const int G = gridDim.x, bx = blockIdx.x, vcu = (G % 8 == 0) ? (bx % 8) * (G / 8) + bx / 8 : bx;
        prep_phase(P, vcu * 8 + wave, G * 8, lane);
    }
#ifndef DBL_MASK
#define DBL_MASK 0
#endif
    int rep = 0;
#pragma unroll 1
    for (int step = 0; step < 28; ++step) {
        const int l = step >= 14 ? 1 : 0, s = step - 14 * l;
        if (((DBL_MASK >> s) & 1) && rep == 0) { rep = 1; --step; } else rep = 0;
        unsigned char* ws = P.ws; asm volatile("" : "+s"(ws));
        const int G = gridDim.x, bx = blockIdx.x;
        bool sync = true;
        {
            const int cpart = (s == 0) ? (l == 0 ? 2 : 0) : ((s == 1 && l == 1) ? 1 : -1);
#ifndef NO_CONV
            if (cpart >= 0) {
                const int tid = opaque_tid(), lane = tid & 63, wave = __builtin_amdgcn_readfirstlane(tid >> 6);
                const int vcu = (G % 8 == 0) ? (bx % 8) * (G / 8) + bx / 8 : bx;
                convert_weights(P, l, (LAS unsigned char*)lds, vcu * 8 + wave, G * 8, wave, lane, cpart);
                __syncthreads();
            }
#endif
        }
        if (s == 0 || s == 5 || s == 6) {
            const int tid = opaque_tid(), lane = tid & 63, wave = __builtin_amdgcn_readfirstlane(tid >> 6);
            const int vcu = (G % 8 == 0) ? (bx % 8) * (G / 8) + bx / 8 : bx;
            if (s == 0) {
            } else if (s == 5) {
#ifndef NO_MIX
                mix_phase(P, l, vcu * 8 + wave, G * 8, lane, (LAS unsigned char*)lds);
#endif
            } else {
#ifndef NO_ATTN
                att::Tens T{ws}; att::attn_phase((char*)lds, T, vcu, G, ((DBL_MASK >> 6) & 1) && rep == 1, l == 0);
#endif
            }
        } else {
            const int gid = s < 5 ? s - 1 : s - 3;
            sync = !(gid == 1 || gid == 2 || gid == 5 || gid == 6 || (gid == 10 && l == 0));
            pg8::GDesc d; fill_desc(d, P, ws, l, gid);
#ifndef NO_GEMM
            if (!(l == 1 && gid >= 4)) pg8::skinny_gemm((LAS unsigned char*)lds, d, G, bx);
            pg8::gemm_generic((LAS unsigned char*)lds, d, G, bx);
#endif
        }
        if (sync && step != 27) { if (step == 0) grid.sync(); else xcd_barrier(bar); }
    }
}

extern "C" void kernel_launch(void* const* d_in, const int* in_sizes, int n_in, void* d_out, int out_size, void* d_ws, size_t ws_size, hipStream_t stream) {
    static int grid_blocks = 0;
    if (grid_blocks == 0) {
        if (n_in != 20 || ws_size < WS_NEED || out_size != MREAL * DM) { fprintf(stderr, "kernel_launch: unexpected shapes (n_in %d, ws %zu need %zu, out %d)\n", n_in, ws_size, (size_t)WS_NEED, out_size); grid_blocks = -1; return; }
        int dev = 0, cus = 0, per_cu = 0;
        hipGetDevice(&dev);
        hipDeviceGetAttribute(&cus, hipDeviceAttributeMultiprocessorCount, dev);
        hipFuncSetAttribute((const void*)fwd_megakernel, hipFuncAttributeMaxDynamicSharedMemorySize, LDS_BYTES);
        hipOccupancyMaxActiveBlocksPerMultiprocessor(&per_cu, (const void*)fwd_megakernel, 512, LDS_BYTES);
        if (per_cu < 1) { fprintf(stderr, "kernel_launch: occupancy query says %d blocks per CU\n", per_cu); per_cu = 1; }
        (void)hipGetLastError();
        grid_blocks = cus;
    }
    if (grid_blocks < 0) return;
    Params p{};
    p.x = (const float*)d_in[0]; p.meta = (const float*)d_in[1]; p.attn_norm = (const float*)d_in[2]; p.w_in = (const float*)d_in[3]; p.conv_w = (const float*)d_in[4];
    p.q_lat_norm = (const float*)d_in[5]; p.kv_lat_norm = (const float*)d_in[6]; p.w_uq = (const float*)d_in[7]; p.w_ukv = (const float*)d_in[8]; p.q_norm = (const float*)d_in[9];
    p.k_norm = (const float*)d_in[10]; p.pool_w = (const float*)d_in[11]; p.pool_scale = (const float*)d_in[12]; p.w_a = (const float*)d_in[13]; p.w_b = (const float*)d_in[14];
    p.w_c = (const float*)d_in[15]; p.w_o = (const float*)d_in[16]; p.mlp_norm = (const float*)d_in[17]; p.w_up = (const float*)d_in[18]; p.w_down = (const float*)d_in[19];
    p.out = (float*)d_out; p.ws = (unsigned char*)d_ws;
    if (hipMemsetAsync((char*)d_ws + OFF_BAR, 0, BAR_BYTES, stream) != hipSuccess) { fprintf(stderr, "kernel_launch: memset of barrier words failed\n"); return; }
    void* args[] = {&p};
    hipError_t e = hipLaunchCooperativeKernel((const void*)fwd_megakernel, dim3(grid_blocks), dim3(512), args, LDS_BYTES, stream);
    if (e != hipSuccess) fprintf(stderr, "cooperative launch failed: %s (grid %d)\n", hipGetErrorString(e), grid_blocks);
}
```
